# Optimizing an MI355X kernel written in HIP

```python
import math
import jax, jax.numpy as jnp
from jax import lax
import numpy as np

D_MODEL = 1024
BATCH = 8
SEQ = 2048
DEPTH = 1

D_MIX = D_MODEL
D_HYENA = D_MIX // 2
D_ATTN = D_MIX - D_HYENA
HEAD_DIM = 64
N_HEADS = D_ATTN // HEAD_DIM
HYENA_ORDER = 2
SHORT_CONV = 3
FILTER_EMB = 33
FILTER_BANDS = (FILTER_EMB - 1) // 2
FILTER_WIDTH = 64
N_DIRS = 2
DECAY_TARGET = 1e-2
FAST_DECAY_PCT = 0.3
SLOW_DECAY_PCT = 1.5
DILATED_PATTERNS = ((128, 1), (512, 4), (2048, 16))
D_FF = 2816
RMS_EPS = 1e-6
NEG_INF = -1e30

kernel_name = "hybrid_hyena_dilated_attn_macaron_block"


def rmsnorm(x, g):
    xf = x.astype(jnp.float32)
    y = xf * lax.rsqrt(jnp.mean(xf * xf, axis=-1, keepdims=True) + RMS_EPS)
    return (y * g.astype(jnp.float32)).astype(x.dtype)


def swiglu(h, w_gate, w_up, w_down):
    return (jax.nn.silu(h @ w_gate) * (h @ w_up)) @ w_down


def alibi_slopes():
    return jnp.asarray(np.array([2.0 ** (-8.0 * (i + 1) / N_HEADS) for i in range(N_HEADS)], np.float32))


def short_conv(u, w, b):
    L = u.shape[1]
    r = SHORT_CONV // 2
    up = jnp.pad(u, ((0, 0), (r, r), (0, 0)))
    y = b
    for i in range(SHORT_CONV):
        y = y + up[:, i:i + L] * w[i]
    return y


def hyena_filters(L, fw1, fb1, fw2, fb2, fw3, fb3, fw_out, f_freq):
    t = jnp.linspace(0.0, 1.0, L, dtype=jnp.float32)[:, None]
    w = 2.0 * math.pi * jnp.arange(L, dtype=jnp.float32)[:, None] / L
    f = jnp.linspace(1e-4, FILTER_BANDS - 1, FILTER_BANDS, dtype=jnp.float32)[None, :]
    z = jnp.concatenate([t, jnp.cos(f * w), -jnp.sin(f * w)], axis=-1)
    freq = f_freq.astype(jnp.float32)
    h = jnp.sin(freq * (z @ fw1.astype(jnp.float32) + fb1.astype(jnp.float32)))
    h = jnp.sin(freq * (h @ fw2.astype(jnp.float32) + fb2.astype(jnp.float32)))
    h = jnp.sin(freq * (h @ fw3.astype(jnp.float32) + fb3.astype(jnp.float32)))
    k = (h @ fw_out.astype(jnp.float32)).reshape(L, HYENA_ORDER, N_DIRS, D_HYENA)
    max_decay = math.log(DECAY_TARGET) / FAST_DECAY_PCT
    min_decay = math.log(DECAY_TARGET) / SLOW_DECAY_PCT
    deltas = jnp.linspace(min_decay, max_decay, D_HYENA, dtype=jnp.float32)
    decay = jnp.exp(-t * jnp.abs(deltas)[None, :])
    return k * decay[:, None, None, :]


def bidir_long_conv(u, h_fwd, h_bwd, skip):
    L = u.shape[1]
    h_full = jnp.concatenate([h_fwd, jnp.zeros_like(h_fwd[:1]), h_bwd[:0:-1]], axis=0)
    Hf = jnp.fft.rfft(h_full, axis=0)
    U = jnp.fft.rfft(u, n=2 * L, axis=1)
    y = jnp.fft.irfft(U * Hf[None], n=2 * L, axis=1)[:, :L]
    return y + u * skip


def hyena_mixer(u3, conv_w, conv_b, fw1, fb1, fw2, fb2, fw3, fb3, fw_out, f_freq, f_skip):
    L = u3.shape[1]
    u = short_conv(u3.astype(jnp.float32), conv_w.astype(jnp.float32), conv_b.astype(jnp.float32))
    v, x1, x2 = jnp.split(u, 3, axis=-1)
    filt = hyena_filters(L, fw1, fb1, fw2, fb2, fw3, fb3, fw_out, f_freq)
    skip = f_skip.astype(jnp.float32)
    z = v
    for o, gate in enumerate((x1, x2)):
        z = gate * bidir_long_conv(z, filt[:, o, 0], filt[:, o, 1], skip[o])
    return z


def dilated_window_attention(q, k, v, window, dilation, slopes):
    B, S, H, Dh = q.shape
    R = window // (2 * dilation)
    Lsub = S // dilation
    nblk = -(-Lsub // R)
    Lp = nblk * R

    def to_sub(a):
        return a.reshape(B, Lsub, dilation, H, Dh).transpose(0, 2, 3, 1, 4)

    qs, ks, vs = to_sub(q), to_sub(k), to_sub(v)
    qs = jnp.pad(qs, ((0, 0), (0, 0), (0, 0), (0, Lp - Lsub), (0, 0)))
    pad_kv = ((0, 0), (0, 0), (0, 0), (R, Lp - Lsub + R), (0, 0))
    ks, vs = jnp.pad(ks, pad_kv), jnp.pad(vs, pad_kv)
    qb = qs.reshape(B, dilation, H, nblk, R, Dh)

    def band(a):
        ab = a.reshape(B, dilation, H, nblk + 2, R, Dh)
        return jnp.concatenate([ab[:, :, :, :nblk], ab[:, :, :, 1:nblk + 1], ab[:, :, :, 2:]], axis=4)

    kb, vb = band(ks), band(vs)
    scores = jnp.einsum('bdhnqc,bdhnkc->bdhnqk', qb, kb) / math.sqrt(Dh)
    qi = jnp.arange(nblk)[:, None, None] * R + jnp.arange(R)[None, :, None]
    kj = jnp.arange(nblk)[:, None, None] * R + jnp.arange(3 * R)[None, None, :] - R
    rel = kj - qi
    valid = (jnp.abs(rel) <= R) & (kj >= 0) & (kj < Lsub)
    alibi = -slopes[:, None, None, None] * (dilation * jnp.abs(rel)).astype(jnp.float32)[None]
    scores = jnp.where(valid, scores + alibi[None, None], NEG_INF)
    m = jnp.max(scores, axis=-1, keepdims=True)
    p = jnp.exp(scores - m)
    den = jnp.sum(p, axis=-1, keepdims=True)
    out = jnp.einsum('bdhnqk,bdhnkc->bdhnqc', p, vb) / den
    lse = (m + jnp.log(den))[..., 0]
    out = out.reshape(B, dilation, H, Lp, Dh)[:, :, :, :Lsub].transpose(0, 3, 1, 2, 4).reshape(B, S, H, Dh)
    lse = lse.reshape(B, dilation, H, Lp)[..., :Lsub].transpose(0, 3, 1, 2).reshape(B, S, H)
    return out, lse


def dilated_attention_mixer(a3):
    B, S, _ = a3.shape
    a3 = a3.astype(jnp.float32)
    q, k, v = [t.reshape(B, S, N_HEADS, HEAD_DIM) for t in jnp.split(a3, 3, axis=-1)]
    slopes = alibi_slopes()
    outs, lses = [], []
    for window, dilation in DILATED_PATTERNS:
        o, l = dilated_window_attention(q, k, v, window, dilation, slopes)
        outs.append(o)
        lses.append(l)
    wts = jax.nn.softmax(jnp.stack(lses, axis=0), axis=0)
    out = jnp.sum(wts[..., None] * jnp.stack(outs, axis=0), axis=0)
    return out.reshape(B, S, D_ATTN)


def setup_inputs(seed: int = 0) -> dict:
    key = jax.random.key(seed)
    ks = jax.random.split(key, 32)
    f32 = jnp.float32
    nrm = lambda k, shape, s: jax.random.normal(k, shape, f32) * s
    gain = lambda k, n: 1.0 + 0.02 * jax.random.normal(k, (n,), f32)
    D, F = D_MODEL, D_FF
    return {
        "x": jax.random.normal(ks[0], (BATCH, SEQ, D), f32),
        "ffn1_norm_g": gain(ks[1], D),
        "ffn1_w_gate": nrm(ks[2], (D, F), D ** -0.5),
        "ffn1_w_up": nrm(ks[3], (D, F), D ** -0.5),
        "ffn1_w_down": nrm(ks[4], (F, D), F ** -0.5),
        "mix_norm_g": gain(ks[5], D),
        "w_in": nrm(ks[6], (D, 3 * D_HYENA + 3 * D_ATTN), D ** -0.5),
        "hy_conv_w": nrm(ks[7], (SHORT_CONV, 3 * D_HYENA), SHORT_CONV ** -0.5),
        "hy_conv_b": nrm(ks[8], (3 * D_HYENA,), 0.02),
        "hy_filt_w1": nrm(ks[9], (FILTER_EMB, FILTER_WIDTH), FILTER_EMB ** -0.5),
        "hy_filt_b1": nrm(ks[10], (FILTER_WIDTH,), 0.1),
        "hy_filt_w2": nrm(ks[11], (FILTER_WIDTH, FILTER_WIDTH), FILTER_WIDTH ** -0.5),
        "hy_filt_b2": nrm(ks[12], (FILTER_WIDTH,), 0.1),
        "hy_filt_w3": nrm(ks[13], (FILTER_WIDTH, FILTER_WIDTH), FILTER_WIDTH ** -0.5),
        "hy_filt_b3": nrm(ks[14], (FILTER_WIDTH,), 0.1),
        "hy_filt_w_out": nrm(ks[15], (FILTER_WIDTH, HYENA_ORDER * N_DIRS * D_HYENA), 0.1 * FILTER_WIDTH ** -0.5),
        "hy_filt_freq": 1.0 + 0.1 * jax.random.normal(ks[16], (FILTER_WIDTH,), f32),
        "hy_filt_skip": nrm(ks[17], (HYENA_ORDER, D_HYENA), 0.5),
        "hy_out_norm_g": gain(ks[18], D_HYENA),
        "attn_out_norm_g": gain(ks[19], D_ATTN),
        "w_out": nrm(ks[20], (D_MIX, D), D_MIX ** -0.5),
        "ffn2_norm_g": gain(ks[21], D),
        "ffn2_w_gate": nrm(ks[22], (D, F), D ** -0.5),
        "ffn2_w_up": nrm(ks[23], (D, F), D ** -0.5),
        "ffn2_w_down": nrm(ks[24], (F, D), F ** -0.5),
        "final_norm_g": gain(ks[25], D),
    }


def reference(x, ffn1_norm_g, ffn1_w_gate, ffn1_w_up, ffn1_w_down, mix_norm_g, w_in,
              hy_conv_w, hy_conv_b, hy_filt_w1, hy_filt_b1, hy_filt_w2, hy_filt_b2,
              hy_filt_w3, hy_filt_b3, hy_filt_w_out, hy_filt_freq, hy_filt_skip,
              hy_out_norm_g, attn_out_norm_g, w_out, ffn2_norm_g, ffn2_w_gate, ffn2_w_up,
              ffn2_w_down, final_norm_g):
    for _ in range(DEPTH):
        x = x + 0.5 * swiglu(rmsnorm(x, ffn1_norm_g), ffn1_w_gate, ffn1_w_up, ffn1_w_down)
        h = rmsnorm(x, mix_norm_g)
        proj = h @ w_in
        y_hy = hyena_mixer(proj[..., :3 * D_HYENA], hy_conv_w, hy_conv_b,
                           hy_filt_w1, hy_filt_b1, hy_filt_w2, hy_filt_b2,
                           hy_filt_w3, hy_filt_b3, hy_filt_w_out, hy_filt_freq, hy_filt_skip)
        y_at = dilated_attention_mixer(proj[..., 3 * D_HYENA:])
        y = jnp.concatenate([rmsnorm(y_hy, hy_out_norm_g), rmsnorm(y_at, attn_out_norm_g)], axis=-1)
        x = x + (y.astype(x.dtype) @ w_out)
        x = x + 0.5 * swiglu(rmsnorm(x, ffn2_norm_g), ffn2_w_gate, ffn2_w_up, ffn2_w_down)
    return rmsnorm(x, final_norm_g)
```

```cpp
#include <hip/hip_runtime.h>
#include <hip/hip_cooperative_groups.h>
#include <cstdio>
#include <cstdint>
namespace cg = cooperative_groups;
namespace pg8 {
#define PG8_LAS __attribute__((address_space(3)))
typedef unsigned short bf16_t;
typedef short bf16x8 __attribute__((ext_vector_type(8)));
typedef float f32x4 __attribute__((ext_vector_type(4)));
typedef unsigned u32x4 __attribute__((ext_vector_type(4)));
constexpr int BM = 256, BK = 64, HALF = 128, HTB = HALF * BK * 2  , STAGE_BYTES = 8 * HTB, NXCD = 8, WGM = 8;

__host__ __device__ __forceinline__ int lds_byte(int r, int c) { const int st = (r >> 4) * 2 + (c >> 5), rr = r & 15, cc = c & 31, ob = rr * 64 + cc * 2; return st * 1024 + (ob ^ (((ob >> 9) & 1) << 5)); }
__host__ __device__ __forceinline__ void stage_rc(int b, int& R, int& C) { const int st = b / 1024, sb = b % 1024, swz = sb ^ (((sb >> 9) & 1) << 5); R = (st >> 1) * 16 + swz / 64; C = (st & 1) * 32 + (swz % 64) / 2; }
__host__ __device__ __forceinline__ int perm32(int rho) { const int n = rho >> 4, i = rho & 15; return 8 * (i >> 2) + 4 * n + (i & 3); }

struct Unit { int pm, pn, z; };
struct Gemm { const bf16_t* A; const bf16_t* Bt; int M, N, K; const bf16_t* A2; const bf16_t* Bt2; };

struct StaticOrder {
    int nM, nN, nwg, G, c;
    __host__ __device__ void init(int M, int N, int G_, int c_) { nM = M / BM; nN = N / BM; nwg = nM * nN; G = G_; c = c_; }
    __host__ __device__ bool next(int i, Unit& u) const {
        const long L = (long)i * G + c; if (L >= nwg) return false;
        int wgid = (int)L; { const int q = nwg / NXCD, r = nwg % NXCD, xcd = wgid % NXCD, off = wgid / NXCD; wgid = (xcd < r ? xcd * (q + 1) : r * (q + 1) + (xcd - r) * q) + off; }
        const int nig = WGM * nN, gid = wgid / nig, fm = gid * WGM, gsz = (nM - fm) < WGM ? (nM - fm) : WGM;
        u.pm = fm + ((wgid % nig) % gsz); u.pn = (wgid % nig) / gsz; u.z = 0; return true;
    }
    __device__ __forceinline__ void a_ready(const Unit&) const {}
    __device__ __forceinline__ void done(const Unit&) const {}
};

__device__ __forceinline__ unsigned cvt_pk_bf16(float lo, float hi) { unsigned r; asm volatile("v_cvt_pk_bf16_f32 %0, %1, %2" : "=v"(r) : "v"(lo), "v"(hi)); return r; }
typedef float f32x2 __attribute__((ext_vector_type(2)));
__device__ __forceinline__ f32x2 gelu_pk(f32x2 v) {
    const f32x2 av = __builtin_elementwise_abs(v), d = av * 0.2316418882f + 1.0f;
    f32x2 t; t.x = __builtin_amdgcn_rcpf(d.x); t.y = __builtin_amdgcn_rcpf(d.y);
    f32x2 q = t * 0.5307027145f + (-0.7265760135f); q = q * t + 0.7107068705f; q = q * t + (-0.142248368f); q = q * t + 0.127414796f; q = q * t;
    const f32x2 s = (v * v) * (-0.72134752044f);
    f32x2 e; e.x = __builtin_amdgcn_exp2f(s.x); e.y = __builtin_amdgcn_exp2f(s.y);
    const f32x2 m = v * (q * e), r = v - m;
    f32x2 o; o.x = v.x < 0.f ? m.x : r.x; o.y = v.y < 0.f ? m.y : r.y; return o;
}

struct EpiSwiglu {
    static constexpr bool PERM = true, AFTER_DRAIN = false;
    bf16_t* H; int ldh;
    __device__ __forceinline__ void operator()(const f32x4 (&acc)[2][2][4][2], const Unit& u, int wr, int wc, int fr, int fq) const {
        const int row0 = u.pm * BM + wr * 64 + fr, col0 = u.pn * HALF + wc * 32 + 8 * fq;
#pragma unroll
        for (int ai = 0; ai < 2; ++ai)
#pragma unroll
            for (int m = 0; m < 4; ++m) { bf16_t* rowp = H + (size_t)(row0 + ai * HALF + m * 16) * ldh + col0;
                float o[8];
#pragma unroll
                for (int n = 0; n < 2; ++n)
#pragma unroll
                    for (int e = 0; e < 4; ++e) { const float g = acc[ai][0][m][n][e], up = acc[ai][1][m][n][e];
                        const float sg = g * __builtin_amdgcn_rcpf(1.0f + __builtin_amdgcn_exp2f(-1.4426950408889634f * g)); o[n * 4 + e] = sg * up; }
                u32x4 w; w.x = cvt_pk_bf16(o[0], o[1]); w.y = cvt_pk_bf16(o[2], o[3]); w.z = cvt_pk_bf16(o[4], o[5]); w.w = cvt_pk_bf16(o[6], o[7]);
                *(u32x4*)rowp = w; }
    }
};
struct EpiResid {
    static constexpr bool PERM = false, AFTER_DRAIN = false;
    const float* base; float* out; int ldc; float scale;
    __device__ __forceinline__ void operator()(const f32x4 (&acc)[2][2][4][2], const Unit& u, int wr, int wc, int fr, int fq) const {
        const int row0 = u.pm * BM + wr * 64 + fr, col0 = u.pn * BM + wc * 32 + 4 * fq;
#pragma unroll
        for (int ai = 0; ai < 2; ++ai)
#pragma unroll
            for (int m = 0; m < 4; ++m) { const size_t off = (size_t)(row0 + ai * HALF + m * 16) * ldc + col0;
#pragma unroll
                for (int bj = 0; bj < 2; ++bj)
#pragma unroll
                    for (int n = 0; n < 2; ++n) { const f32x4 bs = *(const f32x4*)(base + off + bj * HALF + n * 16);
                        *(f32x4*)(out + off + bj * HALF + n * 16) = bs + acc[ai][bj][m][n] * scale; } }
    }
};
struct EpiStore2 {
    static constexpr bool PERM = true, AFTER_DRAIN = false;
    bf16_t* O0; int ld0; bf16_t* O1; int ld1;
    __device__ __forceinline__ void operator()(const f32x4 (&acc)[2][2][4][2], const Unit& u, int wr, int wc, int fr, int fq) const {
        bf16_t* O = u.z ? O1 : O0; const int ldc = u.z ? ld1 : ld0;
        const int row0 = u.pm * BM + wr * 64 + fr, col0 = u.pn * BM + wc * 32 + 8 * fq;
#pragma unroll
        for (int ai = 0; ai < 2; ++ai)
#pragma unroll
            for (int m = 0; m < 4; ++m) { bf16_t* rowp = O + (size_t)(row0 + ai * HALF + m * 16) * ldc + col0;
#pragma unroll
                for (int bj = 0; bj < 2; ++bj) { const f32x4 v0 = acc[ai][bj][m][0], v1 = acc[ai][bj][m][1];
                    u32x4 w; w.x = cvt_pk_bf16(v0[0], v0[1]); w.y = cvt_pk_bf16(v0[2], v0[3]); w.z = cvt_pk_bf16(v1[0], v1[1]); w.w = cvt_pk_bf16(v1[2], v1[3]);
                    *(u32x4*)(rowp + bj * HALF) = w; } }
    }
};
struct WinOrder {
    StaticOrder so;
    __host__ __device__ void init(int G_, int c_) { so.init(64 * BM, 12 * BM, G_, c_); }
    __host__ __device__ bool next(int i, Unit& u) const {
        Unit v; if (!so.next(i, v)) return false;
        if (v.pn < 6) { u.pm = v.pn; u.pn = v.pm; u.z = 0; } else { u.pm = v.pm; u.pn = v.pn - 6; u.z = 1; }
        return true;
    }
    __device__ __forceinline__ void a_ready(const Unit&) const {}
    __device__ __forceinline__ void done(const Unit&) const {}
};
template <class Epi, class Sched, bool ALIGN_EPI = false, bool SP2 = false>
__device__ __forceinline__ void gemm_phase(PG8_LAS unsigned char* lds, const Gemm g, const Sched& S, const Epi& E) {
    const int tid = threadIdx.x, wid = __builtin_amdgcn_readfirstlane(tid >> 6), lane = tid & 63, wr = wid >> 2, wc = wid & 3, fr = lane & 15, fq = lane >> 4;
    const int K = g.K, nt = K / BK;
    unsigned voffA[2], voffB[2];
#pragma unroll
    for (int i = 0; i < 2; ++i) { int R, C; stage_rc(tid * 16 + i * 8192, R, C); const int Rb = Epi::PERM ? ((R & ~31) + perm32(R & 31)) : R;
        voffA[i] = (unsigned)(R * K + C) * 2u; voffB[i] = (unsigned)(Rb * K + C) * 2u; }
    const size_t kstep = (size_t)(BK * 2);
    const size_t hstep = (size_t)HALF * K * 2;
    const size_t tstep = 2 * hstep;
    const unsigned ldsw = (unsigned)wid * 1024u;
    const int aoff = lds_byte(wr * 64 + fr, fq * 8), boff = lds_byte(wc * 32 + fr, fq * 8);
#define PG8_SA(b, h) (((b) * 2 + (h)) * HTB)
#define PG8_SB(b, h) ((4 + (b) * 2 + (h)) * HTB)
#define PG8_STAGE(bufoff, gbase, voff) do { _Pragma("unroll") for (int _i = 0; _i < 2; ++_i) \
        __builtin_amdgcn_global_load_lds((const unsigned*)((const char*)(gbase) + (voff)[_i]), (PG8_LAS unsigned*)(lds + (bufoff) + ldsw + _i * 8192), 16, 0, 0); } while (0)
#define PG8_LDA(dst, b, h) do { _Pragma("unroll") for (int m = 0; m < 4; ++m) _Pragma("unroll") for (int k = 0; k < 2; ++k) dst[m][k] = *(const PG8_LAS bf16x8*)(lds + PG8_SA(b, h) + aoff + m * 2048 + k * 1024); } while (0)
#define PG8_LDB(dst, b, h) do { _Pragma("unroll") for (int n = 0; n < 2; ++n) _Pragma("unroll") for (int k = 0; k < 2; ++k) dst[n][k] = *(const PG8_LAS bf16x8*)(lds + PG8_SB(b, h) + boff + n * 2048 + k * 1024); } while (0)
#define PG8_MMA(ai, bj, At, Bt) do { __builtin_amdgcn_s_setprio(1); _Pragma("unroll") for (int m = 0; m < 4; ++m) _Pragma("unroll") for (int n = 0; n < 2; ++n) _Pragma("unroll") for (int k = 0; k < 2; ++k) \
        acc[ai][bj][m][n] = __builtin_amdgcn_mfma_f32_16x16x32_bf16(Bt[n][k], At[m][k], acc[ai][bj][m][n], 0, 0, 0); __builtin_amdgcn_s_setprio(0); } while (0)
#define PG8_WAIT_V(n) asm volatile("s_waitcnt vmcnt(" #n ")" ::: "memory")
#define PG8_WAIT_L(n) asm volatile("s_waitcnt lgkmcnt(" #n ")" ::: "memory")
#define PG8_BAR __builtin_amdgcn_s_barrier()
#define PG8_SCHED __builtin_amdgcn_sched_barrier(0)
    Unit cur, nxt; int ui = 0;
    if (!S.next(0, cur)) return;
    f32x4 acc[2][2][4][2];
#pragma unroll
    for (int a = 0; a < 2; ++a)
#pragma unroll
        for (int b = 0; b < 2; ++b)
#pragma unroll
            for (int m = 0; m < 4; ++m)
#pragma unroll
                for (int n = 0; n < 2; ++n) acc[a][b][m][n] = (f32x4){0.f, 0.f, 0.f, 0.f};
    bf16x8 At[4][2], B0[2][2], B1[2][2];
    const char* cA = (const char*)(cur.z ? g.A2 : g.A) + (size_t)cur.pm * tstep; const char* cB = (const char*)(cur.z ? g.Bt2 : g.Bt) + (size_t)cur.pn * tstep;
    S.a_ready(cur);
    if constexpr (SP2) {
        PG8_STAGE(PG8_SB(0, 0), cB, voffB); PG8_STAGE(PG8_SB(0, 1), cB + hstep, voffB); PG8_STAGE(PG8_SA(0, 0), cA, voffA); PG8_STAGE(PG8_SA(0, 1), cA + hstep, voffA);
        if (wr == 1) PG8_BAR;
        PG8_WAIT_V(2); PG8_BAR;
        PG8_STAGE(PG8_SB(1, 0), cB + kstep, voffB); PG8_STAGE(PG8_SA(1, 0), cA + kstep, voffA); PG8_STAGE(PG8_SB(1, 1), cB + hstep + kstep, voffB);
        PG8_WAIT_V(6); PG8_BAR;
    } else {
        PG8_STAGE(PG8_SB(0, 0), cB, voffB); PG8_STAGE(PG8_SA(0, 0), cA, voffA); PG8_STAGE(PG8_SB(0, 1), cB + hstep, voffB); PG8_STAGE(PG8_SA(0, 1), cA + hstep, voffA);
        if (wr == 1) PG8_BAR;
        PG8_WAIT_V(4); PG8_BAR;
        PG8_STAGE(PG8_SB(1, 0), cB + kstep, voffB); PG8_STAGE(PG8_SA(1, 0), cA + kstep, voffA); PG8_STAGE(PG8_SB(1, 1), cB + hstep + kstep, voffB);
        PG8_WAIT_V(6); PG8_BAR;
    }
    for (;;) {
        const bool has_next = S.next(ui + 1, nxt);
        const char* nA = has_next ? (const char*)(nxt.z ? g.A2 : g.A) + (size_t)nxt.pm * tstep : cA; const char* nB = has_next ? (const char*)(nxt.z ? g.Bt2 : g.Bt) + (size_t)nxt.pn * tstep : cB;
        for (int t = 0; t < nt; t += 2) {
            const bool last = (t == nt - 2);
            const char* a1 = cA + (size_t)(t + 1) * kstep;
            const char* a2 = last ? nA : cA + (size_t)(t + 2) * kstep; const char* b2 = last ? nB : cB + (size_t)(t + 2) * kstep;
            const char* a3 = a2 + kstep; const char* b3 = b2 + kstep;
            if (last && has_next) S.a_ready(nxt);
            if constexpr (SP2) {
            PG8_LDB(B0, 0, 0); PG8_LDB(B1, 0, 1); PG8_SCHED; PG8_LDA(At, 0, 0); PG8_STAGE(PG8_SA(1, 1), a1 + hstep, voffA);
            PG8_WAIT_V(8); PG8_WAIT_L(0); PG8_BAR; PG8_MMA(0, 0, At, B0); PG8_MMA(0, 1, At, B1); PG8_BAR; PG8_SCHED;
            PG8_LDA(At, 0, 1); PG8_STAGE(PG8_SB(0, 0), b2, voffB); PG8_STAGE(PG8_SB(0, 1), b2 + hstep, voffB); PG8_STAGE(PG8_SA(0, 0), a2, voffA);
            PG8_WAIT_V(8); PG8_WAIT_L(0); PG8_BAR; PG8_MMA(1, 0, At, B0); PG8_MMA(1, 1, At, B1); PG8_BAR; PG8_SCHED;
            PG8_LDB(B0, 1, 0); PG8_LDB(B1, 1, 1); PG8_SCHED; PG8_LDA(At, 1, 0); PG8_STAGE(PG8_SA(0, 1), a2 + hstep, voffA);
            PG8_WAIT_V(8); PG8_WAIT_L(0); PG8_BAR; PG8_MMA(0, 0, At, B0); PG8_MMA(0, 1, At, B1); PG8_BAR; PG8_SCHED;
            PG8_LDA(At, 1, 1); PG8_STAGE(PG8_SB(1, 0), b3, voffB); PG8_STAGE(PG8_SB(1, 1), b3 + hstep, voffB); PG8_STAGE(PG8_SA(1, 0), a3, voffA);
            PG8_WAIT_V(8); PG8_WAIT_L(0); PG8_BAR; PG8_MMA(1, 0, At, B0); PG8_MMA(1, 1, At, B1); PG8_BAR; PG8_SCHED;
            } else {
            PG8_LDB(B0, 0, 0); PG8_SCHED; PG8_LDA(At, 0, 0); PG8_STAGE(PG8_SA(1, 1), a1 + hstep, voffA);
            PG8_WAIT_L(8); PG8_BAR; PG8_WAIT_L(0); PG8_MMA(0, 0, At, B0); PG8_BAR; PG8_SCHED;
            PG8_LDB(B1, 0, 1); PG8_STAGE(PG8_SB(0, 0), b2, voffB);
            PG8_BAR; PG8_WAIT_L(0); PG8_MMA(0, 1, At, B1); PG8_BAR;
            PG8_LDA(At, 0, 1); PG8_STAGE(PG8_SA(0, 0), a2, voffA);
            PG8_BAR; PG8_WAIT_L(0); PG8_MMA(1, 0, At, B0); PG8_BAR; PG8_SCHED;
            PG8_STAGE(PG8_SB(0, 1), b2 + hstep, voffB);
            PG8_WAIT_V(6); PG8_BAR; PG8_MMA(1, 1, At, B1); PG8_BAR;
            PG8_LDB(B0, 1, 0); PG8_SCHED; PG8_LDA(At, 1, 0); PG8_STAGE(PG8_SA(0, 1), a2 + hstep, voffA);
            PG8_WAIT_L(8); PG8_BAR; PG8_WAIT_L(0); PG8_MMA(0, 0, At, B0); PG8_BAR; PG8_SCHED;
            PG8_LDB(B1, 1, 1); PG8_STAGE(PG8_SB(1, 0), b3, voffB);
            PG8_BAR; PG8_WAIT_L(0); PG8_MMA(0, 1, At, B1); PG8_BAR;
            PG8_LDA(At, 1, 1); PG8_STAGE(PG8_SA(1, 0), a3, voffA);
            PG8_BAR; PG8_WAIT_L(0); PG8_MMA(1, 0, At, B0); PG8_BAR; PG8_SCHED;
            PG8_STAGE(PG8_SB(1, 1), b3 + hstep, voffB);
            PG8_WAIT_V(6); PG8_BAR; PG8_MMA(1, 1, At, B1); PG8_BAR;
            }
        }
        if constexpr (ALIGN_EPI) { if (wr == 0) PG8_BAR; }
        if constexpr (!Epi::AFTER_DRAIN) { E(acc, cur, wr, wc, fr, fq); S.done(cur); }
        if (!has_next) break;
#pragma unroll
        for (int a = 0; a < 2; ++a)
#pragma unroll
            for (int b = 0; b < 2; ++b)
#pragma unroll
                for (int m = 0; m < 4; ++m)
#pragma unroll
                    for (int n = 0; n < 2; ++n) acc[a][b][m][n] = (f32x4){0.f, 0.f, 0.f, 0.f};
        cur = nxt; cA = nA; cB = nB; ++ui;
        if constexpr (ALIGN_EPI) { if (wr == 1) PG8_BAR; }
    }
    PG8_WAIT_V(0);
    if constexpr (!ALIGN_EPI) { if (wr == 0) PG8_BAR; }
    PG8_BAR;
    if constexpr (Epi::AFTER_DRAIN) { E.fused(acc, cur, wr, wc, fr, fq, lds, wid, lane); S.done(cur); }
#undef PG8_SA
#undef PG8_SB
#undef PG8_STAGE
#undef PG8_LDA
#undef PG8_LDB
#undef PG8_MMA
#undef PG8_WAIT_V
#undef PG8_WAIT_L
#undef PG8_BAR
#undef PG8_SCHED
}
}
constexpr int NWAVES = 8;
constexpr int M = 16384, D = 1024, FF = 2816, NBATCH = 8, SEQ = 2048, DH = 512, NQKV = 1536;
constexpr float RMS_EPS = 1e-6f;
constexpr int LDS_BYTES = 147456;
constexpr size_t MiB = 1u << 20;
constexpr size_t WS_W1A = 0, WS_W1D = 11 * MiB, WS_WIN = 17 * MiB, WS_WOUT = 23 * MiB, WS_W2A = 25 * MiB, WS_W2D = 36 * MiB;
constexpr size_t WS_XN = 42 * MiB;
constexpr size_t WS_H = 74 * MiB;
constexpr size_t WS_PT = 74 * MiB;
constexpr size_t WS_QKV = 122 * MiB;
constexpr size_t WS_YHT = 170 * MiB;
constexpr size_t WS_YA = 186 * MiB;
constexpr size_t WS_Y = 202 * MiB;
constexpr size_t WS_G = 234 * MiB;
constexpr size_t WS_H3 = 242 * MiB;
constexpr size_t WS_END = 243 * MiB;

#define LAS __attribute__((address_space(3)))
typedef unsigned short bf16;
typedef float f32x4 __attribute__((ext_vector_type(4)));
typedef unsigned u32x4 __attribute__((ext_vector_type(4)));
typedef unsigned u32x2 __attribute__((ext_vector_type(2)));
typedef short bf16x8 __attribute__((ext_vector_type(8)));
typedef short s16x4 __attribute__((ext_vector_type(4)));
#define LDS_WAIT() asm volatile("s_waitcnt lgkmcnt(0)" ::: "memory")
using pg8::cvt_pk_bf16;
__device__ __forceinline__ float bf2f(unsigned v) { return __uint_as_float(v << 16); }
__device__ __forceinline__ unsigned f2bf(float f) { return cvt_pk_bf16(f, 0.f) & 0xffffu; }
__device__ __forceinline__ float wave_sum(float v) {
#pragma unroll
    for (int o = 1; o < 64; o <<= 1) v += __shfl_xor(v, o);
    return v;
}

struct Params { const float* in[26]; float* out; unsigned char* ws; };
enum { I_X = 0, I_G1, I_WG1, I_WU1, I_WD1, I_GMIX, I_WIN, I_CW, I_CB, I_FW1, I_FB1, I_FW2, I_FB2, I_FW3, I_FB3, I_FWO, I_FREQ, I_SKIP, I_GHY, I_GAT, I_WOUT, I_G2, I_WG2, I_WU2, I_WD2, I_GFIN };

__device__ __forceinline__ void p0_transpose_item(const float* W, int K, int N, bf16* WT, int k0, int n0, int drow0, LAS float* scr, int lane) {
#pragma unroll 8
    for (int i = 0; i < 32; ++i) { const int kk = 2 * i + (lane >> 5); scr[kk * 33 + (lane & 31)] = W[(size_t)(k0 + kk) * N + n0 + (lane & 31)]; }
    LDS_WAIT();
    const int c = lane & 7;
#pragma unroll
    for (int j = 0; j < 4; ++j) { const int n = (lane >> 3) + 8 * j; const LAS float* s = scr + (8 * c) * 33 + n;
        u32x4 o; o.x = cvt_pk_bf16(s[0 * 33], s[1 * 33]); o.y = cvt_pk_bf16(s[2 * 33], s[3 * 33]); o.z = cvt_pk_bf16(s[4 * 33], s[5 * 33]); o.w = cvt_pk_bf16(s[6 * 33], s[7 * 33]);
        *(u32x4*)(WT + (size_t)(drow0 + n) * K + k0 + 8 * c) = o; }
    LDS_WAIT();
}
__device__ __forceinline__ void p0_transpose_mat(const float* W, int K, int N, bf16* WT, int mode, int item, LAS float* scr, int lane) {
    const int nblk = N / 32, kb = item / nblk, nb = item % nblk, n0 = 32 * nb;
    const int drow0 = mode == 0 ? n0 : (256 * (n0 / 128) + (n0 % 128) + (mode == 2 ? 128 : 0));
    p0_transpose_item(W, K, N, WT, 64 * kb, n0, drow0, scr, lane);
}
__device__ __forceinline__ void rms_row_to_bf16(const float* xrow, const float* g, bf16* orow, int lane) {
    const f32x4* xr = (const f32x4*)xrow + lane; const f32x4* gr = (const f32x4*)g + lane;
    f32x4 v[4]; float s = 0.f;
#pragma unroll
    for (int j = 0; j < 4; ++j) { v[j] = xr[64 * j]; s += (v[j].x * v[j].x + v[j].y * v[j].y) + (v[j].z * v[j].z + v[j].w * v[j].w); }
    const float rstd = 1.0f / sqrtf(wave_sum(s) * (1.f / D) + RMS_EPS);
    u32x2* o8 = (u32x2*)orow + lane;
#pragma unroll
    for (int j = 0; j < 4; ++j) { const f32x4 gv = gr[64 * j]; u32x2 w; w.x = cvt_pk_bf16(v[j].x * rstd * gv.x, v[j].y * rstd * gv.y); w.y = cvt_pk_bf16(v[j].z * rstd * gv.z, v[j].w * rstd * gv.w); o8[64 * j] = w; }
}
__device__ __forceinline__ void rms_row_to_f32(const float* xrow, const float* g, float* orow, int lane) {
    const f32x4* xr = (const f32x4*)xrow + lane; const f32x4* gr = (const f32x4*)g + lane;
    f32x4 v[4]; float s = 0.f;
#pragma unroll
    for (int j = 0; j < 4; ++j) { v[j] = xr[64 * j]; s += (v[j].x * v[j].x + v[j].y * v[j].y) + (v[j].z * v[j].z + v[j].w * v[j].w); }
    const float rstd = 1.0f / sqrtf(wave_sum(s) * (1.f / D) + RMS_EPS);
    f32x4* o = (f32x4*)orow + lane;
#pragma unroll
    for (int j = 0; j < 4; ++j) { const f32x4 gv = gr[64 * j]; o[64 * j] = v[j] * rstd * gv; }
}

__device__ __forceinline__ void filt_stage1(const Params& p, LAS unsigned char* lds, int tid) {
    const int wave = tid >> 6, j = tid & 63;
    LAS float* zb = (LAS float*)lds + wave * 192; LAS float* ha = zb + 64; LAS float* hb = zb + 128;
    LAS float* w1l = (LAS float*)(lds + 8192); LAS float* w2l = w1l + 33 * 64; LAS float* w3l = w2l + 64 * 64;
    float* H3 = (float*)(p.ws + WS_H3);
    for (int i = tid; i < 33 * 64; i += NWAVES * 64) w1l[i] = p.in[I_FW1][i];
    for (int i = tid; i < 64 * 64; i += NWAVES * 64) { w2l[i] = p.in[I_FW2][i]; w3l[i] = p.in[I_FW3][i]; }
    const float fq = p.in[I_FREQ][j], b1 = p.in[I_FB1][j], b2 = p.in[I_FB2][j], b3 = p.in[I_FB3][j];
    __syncthreads();
    for (int base = blockIdx.x * 8; base < SEQ; base += gridDim.x * 8) {
        const int pos = base + wave;
        const float tl = (float)pos / 2047.0f, w = (6.283185307179586f * (float)pos) / 2048.0f;
        if (j < 33) { float z; if (j == 0) z = tl; else { const int i = (j - 1) & 15; const float f = 1e-4f + (float)i * ((15.0f - 1e-4f) / 15.0f); z = (j <= 16) ? cosf(f * w) : -sinf(f * w); } zb[j] = z; }
        __syncthreads();
        { float a = b1;
#pragma unroll
          for (int i = 0; i < 33; ++i) a += zb[i] * w1l[i * 64 + j];
          ha[j] = sinf(fq * a); }
        __syncthreads();
        { float a = b2;
#pragma unroll
          for (int i = 0; i < 64; ++i) a += ha[i] * w2l[i * 64 + j];
          hb[j] = sinf(fq * a); }
        __syncthreads();
        { float a = b3;
#pragma unroll
          for (int i = 0; i < 64; ++i) a += hb[i] * w3l[i * 64 + j];
          H3[pos * 64 + j] = sinf(fq * a); }
        __syncthreads();
    }
}
__device__ __forceinline__ void filt_stage2(const Params& p, LAS unsigned char* lds, int tid) {
    LAS float* wl = (LAS float*)lds;
    const float* H3 = (const float*)(p.ws + WS_H3); bf16* G = (bf16*)(p.ws + WS_G);
    const int e = tid & 7, ps = tid >> 3;
    for (int cb = blockIdx.x; cb < 256; cb += gridDim.x) {
        const int col = 8 * cb + e, o = col >> 10, dir = (col >> 9) & 1, c = col & 511;
        __syncthreads();
        wl[(tid & 7) * 64 + (tid >> 3)] = p.in[I_FWO][(size_t)(tid >> 3) * 2048 + 8 * cb + (tid & 7)];
        __syncthreads();
        const float ad = 3.0701134573253943f + (float)c * ((15.350567286626972f - 3.0701134573253943f) / 511.0f);
        bf16* gp = G + (size_t)(c * 2 + o) * 4096;
        const LAS f32x4* wv = (const LAS f32x4*)(wl + e * 64);
#pragma unroll 1
        for (int k = 0; k < 32; ++k) {
            const int pos = 64 * k + ps; const f32x4* hr = (const f32x4*)(H3 + (size_t)pos * 64);
            float acc = 0.f;
#pragma unroll
            for (int q = 0; q < 16; ++q) { const f32x4 hv = hr[q], w4 = wv[q]; acc += (hv.x * w4.x + hv.y * w4.y) + (hv.z * w4.z + hv.w * w4.w); }
            const float val = acc * expf(-((float)pos / 2047.0f) * ad);
            if (dir == 0) gp[2048 + pos] = (bf16)f2bf(val); else if (pos > 0) gp[2048 - pos] = (bf16)f2bf(val); else gp[0] = 0;
        }
    }
    __syncthreads();
}

__device__ __forceinline__ float sconv(const bf16* row, int t, float w0, float w1, float w2, float bias) {
    float a = bias + w1 * bf2f(row[t]);
    if (t > 0) a += w0 * bf2f(row[t - 1]);
    if (t < SEQ - 1) a += w2 * bf2f(row[t + 1]);
    return a;
}
__device__ __forceinline__ void conv_unit_scalar(const Params& p, LAS unsigned char* lds, int c, int tid) {
    LAS float* g = (LAS float*)lds;
    LAS bf16* zA = (LAS bf16*)(lds + 16384);
    LAS bf16* zB = (LAS bf16*)(lds + 16384 + 32768);
    const bf16* PT = (const bf16*)(p.ws + WS_PT); const bf16* G = (const bf16*)(p.ws + WS_G); bf16* YHT = (bf16*)(p.ws + WS_YHT);
    const float* cw = p.in[I_CW]; const float* cb = p.in[I_CB];
    float x1c[4][8], x2c[4][8];
    {
        const float v0 = cw[c], v1 = cw[1536 + c], v2 = cw[3072 + c], vb = cb[c];
        const float a0 = cw[512 + c], a1 = cw[1536 + 512 + c], a2 = cw[3072 + 512 + c], ab = cb[512 + c];
        const float b0 = cw[1024 + c], b1 = cw[1536 + 1024 + c], b2 = cw[3072 + 1024 + c], bb = cb[1024 + c];
#pragma unroll
        for (int k = 0; k < 4; ++k)
#pragma unroll
            for (int b = 0; b < 8; ++b) { const int t = tid + 512 * k;
                zA[b * 2048 + t] = (bf16)f2bf(sconv(PT + (size_t)c * M + b * SEQ, t, v0, v1, v2, vb));
                x1c[k][b] = sconv(PT + (size_t)(512 + c) * M + b * SEQ, t, a0, a1, a2, ab);
                x2c[k][b] = sconv(PT + (size_t)(1024 + c) * M + b * SEQ, t, b0, b1, b2, bb); }
    }
    for (int o = 0; o < 2; ++o) {
        __syncthreads();
#pragma unroll
        for (int e = 0; e < 8; ++e) { const int idx = tid + 512 * e; g[idx] = bf2f(G[(size_t)(c * 2 + o) * 4096 + idx]); }
        __syncthreads();
        const LAS bf16* zin = o ? zB : zA;
        float acc[4][8];
#pragma unroll
        for (int k = 0; k < 4; ++k)
#pragma unroll
            for (int b = 0; b < 8; ++b) acc[k][b] = 0.f;
        for (int s = 0; s < SEQ; ++s) {
            float zv[8];
#pragma unroll
            for (int b = 0; b < 8; ++b) zv[b] = bf2f(zin[b * 2048 + s]);
#pragma unroll
            for (int k = 0; k < 4; ++k) { const float gv = g[2048 + tid + 512 * k - s];
#pragma unroll
                for (int b = 0; b < 8; ++b) acc[k][b] += gv * zv[b]; }
        }
        const float skip = p.in[I_SKIP][o * 512 + c];
#pragma unroll
        for (int k = 0; k < 4; ++k)
#pragma unroll
            for (int b = 0; b < 8; ++b) { const int t = tid + 512 * k; const float y = acc[k][b] + bf2f(zin[b * 2048 + t]) * skip;
                if (o == 0) zB[b * 2048 + t] = (bf16)f2bf(x1c[k][b] * y); else YHT[(size_t)c * M + b * SEQ + t] = (bf16)f2bf(x2c[k][b] * y); }
    }
    __syncthreads();
}
typedef short v4i16_t __attribute__((ext_vector_type(4)));
__device__ __forceinline__ s16x4 vtr(const LAS unsigned char* p) { return __builtin_bit_cast(s16x4, __builtin_amdgcn_ds_read_tr16_b64_v4i16((LAS v4i16_t*)p)); }
constexpr int ATT_VROW = 144;
constexpr int ATT_WAVE_LDS = 32 * ATT_VROW;
constexpr int ATT_NPAIR = 23;
__device__ __forceinline__ void att_pair_params(int pi, int tq0, int& st, int& kb) {
    if (pi < 5) { st = 16; kb = tq0 - 1024 + 512 * pi; }
    else if (pi < 11) { st = 4; kb = tq0 - 256 + 128 * (pi - 5); }
    else { st = 1; kb = tq0 - 64 + 32 * (pi - 11); }
}
__device__ __forceinline__ void att_load(const bf16* QKVb, int h, int st, int kb, int lane, bf16x8 (&kf)[2][2], u32x4 (&vv)[4]) {
    const int fr = lane & 15, fq = lane >> 4;
#pragma unroll
    for (int ab = 0; ab < 2; ++ab) { int tk = kb + st * (16 * ab + fr); tk = tk < 0 ? 0 : (tk > SEQ - 1 ? SEQ - 1 : tk);
        const bf16* kp = QKVb + (size_t)tk * NQKV + 512 + h * 64 + 8 * fq;
        kf[ab][0] = *(const bf16x8*)kp; kf[ab][1] = *(const bf16x8*)(kp + 32); }
#pragma unroll
    for (int e = 0; e < 4; ++e) { int tk = kb + st * (8 * e + (lane >> 3)); tk = tk < 0 ? 0 : (tk > SEQ - 1 ? SEQ - 1 : tk);
        vv[e] = *(const u32x4*)(QKVb + (size_t)tk * NQKV + 1024 + h * 64 + (lane & 7) * 8); }
}
__device__ __forceinline__ void attn_item(const Params& p, LAS unsigned char* vl, int item, int lane) {
    const int rcls = item & 15, stile = (item >> 4) & 7, h = (item >> 7) & 7, b = item >> 10;
    const int fr = lane & 15, fq = lane >> 4;
    const bf16* QKVb = (const bf16*)(p.ws + WS_QKV) + (size_t)b * SEQ * NQKV;
    const int tq0 = 256 * stile + rcls, tq = tq0 + 16 * fr;
    bf16x8 qf[2];
    { const bf16* qp = QKVb + (size_t)tq * NQKV + h * 64 + 8 * fq; qf[0] = *(const bf16x8*)qp; qf[1] = *(const bf16x8*)(qp + 32); }
    const float LOG2E = 1.4426950408889634f, NEG = -1e30f;
    const float slope2 = __builtin_amdgcn_exp2f(-(float)(h + 1)) * LOG2E, sc2 = 0.125f * LOG2E;
    float m = NEG, lpart = 0.f; f32x4 oacc[4];
#pragma unroll
    for (int mt = 0; mt < 4; ++mt) oacc[mt] = (f32x4){0.f, 0.f, 0.f, 0.f};
    bf16x8 kf[2][2], kfn[2][2]; u32x4 vv[4], vvn[4];
    int st, kb; att_pair_params(0, tq0, st, kb); att_load(QKVb, h, st, kb, lane, kf, vv);
    for (int pi = 0; pi < ATT_NPAIR; ++pi) {
        int stn = st, kbn = kb;
        if (pi + 1 < ATT_NPAIR) { att_pair_params(pi + 1, tq0, stn, kbn); att_load(QKVb, h, stn, kbn, lane, kfn, vvn); }
        f32x4 s[2];
#pragma unroll
        for (int ab = 0; ab < 2; ++ab) { s[ab] = (f32x4){0.f, 0.f, 0.f, 0.f};
            s[ab] = __builtin_amdgcn_mfma_f32_16x16x32_bf16(kf[ab][0], qf[0], s[ab], 0, 0, 0);
            s[ab] = __builtin_amdgcn_mfma_f32_16x16x32_bf16(kf[ab][1], qf[1], s[ab], 0, 0, 0); }
        float sv[8]; float mx = NEG;
#pragma unroll
        for (int ab = 0; ab < 2; ++ab)
#pragma unroll
            for (int r = 0; r < 4; ++r) { const int tk = kb + st * (16 * ab + 4 * fq + r); const int dl = tk - tq, adl = dl < 0 ? -dl : dl;
                const bool valid = ((unsigned)tk < (unsigned)SEQ) && (adl <= 64 * st);
                const float x = s[ab][r] * sc2 - slope2 * (float)adl; sv[ab * 4 + r] = valid ? x : NEG; mx = fmaxf(mx, sv[ab * 4 + r]); }
        mx = fmaxf(mx, __shfl_xor(mx, 16)); mx = fmaxf(mx, __shfl_xor(mx, 32));
        const float mnew = fmaxf(m, mx), alpha = __builtin_amdgcn_exp2f(m - mnew); m = mnew;
        float pv[8], ps = 0.f;
#pragma unroll
        for (int i = 0; i < 8; ++i) { pv[i] = sv[i] > -1e29f ? __builtin_amdgcn_exp2f(sv[i] - mnew) : 0.f; ps += pv[i]; }
        lpart = lpart * alpha + ps;
#pragma unroll
        for (int mt = 0; mt < 4; ++mt) oacc[mt] = oacc[mt] * alpha;
        u32x4 pw; pw.x = cvt_pk_bf16(pv[0], pv[1]); pw.y = cvt_pk_bf16(pv[2], pv[3]); pw.z = cvt_pk_bf16(pv[4], pv[5]); pw.w = cvt_pk_bf16(pv[6], pv[7]);
        const bf16x8 pb = __builtin_bit_cast(bf16x8, pw);
        asm volatile("" ::: "memory");
#pragma unroll
        for (int e = 0; e < 4; ++e) *(LAS u32x4*)(vl + (8 * e + (lane >> 3)) * ATT_VROW + (lane & 7) * 16) = vv[e];
        LDS_WAIT();
        const LAS unsigned char* va = vl + (4 * fq + (fr >> 2)) * ATT_VROW + (fr & 3) * 8;
#pragma unroll
        for (int mt = 0; mt < 4; ++mt) { const s16x4 lo = vtr(va + mt * 32), hi = vtr(va + 16 * ATT_VROW + mt * 32);
            const bf16x8 vf = (bf16x8){lo[0], lo[1], lo[2], lo[3], hi[0], hi[1], hi[2], hi[3]};
            oacc[mt] = __builtin_amdgcn_mfma_f32_16x16x32_bf16(vf, pb, oacc[mt], 0, 0, 0); }
        LDS_WAIT();
        st = stn; kb = kbn;
#pragma unroll
        for (int ab = 0; ab < 2; ++ab) { kf[ab][0] = kfn[ab][0]; kf[ab][1] = kfn[ab][1]; }
#pragma unroll
        for (int e = 0; e < 4; ++e) vv[e] = vvn[e];
    }
    float l = lpart; l += __shfl_xor(l, 16); l += __shfl_xor(l, 32);
    const float inv = 1.0f / l;
    bf16* yp = (bf16*)(p.ws + WS_YA) + (size_t)(b * SEQ + tq) * DH + h * 64 + 4 * fq;
#pragma unroll
    for (int mt = 0; mt < 4; ++mt) { u32x2 w; w.x = cvt_pk_bf16(oacc[mt][0] * inv, oacc[mt][1] * inv); w.y = cvt_pk_bf16(oacc[mt][2] * inv, oacc[mt][3] * inv); *(u32x2*)(yp + 16 * mt) = w; }
}

__device__ __forceinline__ void mixnorm_unit(const Params& p, LAS unsigned char* lds, int unit, int tid) {
    constexpr int RS = 136;
    const int m0 = unit * 64, lane = tid & 63, wave = tid >> 6;
    const bf16* YHT = (const bf16*)(p.ws + WS_YHT); const bf16* YA = (const bf16*)(p.ws + WS_YA); bf16* Y = (bf16*)(p.ws + WS_Y);
    __syncthreads();
    { const u32x4* src = (const u32x4*)(YHT + (size_t)tid * M + m0);
#pragma unroll
        for (int q = 0; q < 8; ++q) { const u32x4 v = src[q]; LAS unsigned* d = (LAS unsigned*)(lds + tid * RS + q * 16); d[0] = v.x; d[1] = v.y; d[2] = v.z; d[3] = v.w; } }
    __syncthreads();
    const float* ghy = p.in[I_GHY]; const float* gat = p.in[I_GAT];
    for (int k = 0; k < 8; ++k) {
        const int tok = 8 * wave + k, mrow = m0 + tok;
        float v[8]; float s = 0.f;
#pragma unroll
        for (int q = 0; q < 4; ++q) { const int c = 2 * lane + 128 * q;
            v[2 * q] = bf2f(*(const LAS bf16*)(lds + c * RS + tok * 2)); v[2 * q + 1] = bf2f(*(const LAS bf16*)(lds + (c + 1) * RS + tok * 2));
            s += v[2 * q] * v[2 * q] + v[2 * q + 1] * v[2 * q + 1]; }
        const float rstd = 1.0f / sqrtf(wave_sum(s) * (1.f / DH) + RMS_EPS);
#pragma unroll
        for (int q = 0; q < 4; ++q) { const int c = 2 * lane + 128 * q;
            *(unsigned*)(Y + (size_t)mrow * D + c) = cvt_pk_bf16(v[2 * q] * rstd * ghy[c], v[2 * q + 1] * rstd * ghy[c + 1]); }
        const u32x4 a = *(const u32x4*)(YA + (size_t)mrow * DH + 8 * lane);
        float w[8]; w[0] = bf2f(a.x & 0xffffu); w[1] = bf2f(a.x >> 16); w[2] = bf2f(a.y & 0xffffu); w[3] = bf2f(a.y >> 16); w[4] = bf2f(a.z & 0xffffu); w[5] = bf2f(a.z >> 16); w[6] = bf2f(a.w & 0xffffu); w[7] = bf2f(a.w >> 16);
        float s2 = 0.f;
#pragma unroll
        for (int e = 0; e < 8; ++e) s2 += w[e] * w[e];
        const float rstd2 = 1.0f / sqrtf(wave_sum(s2) * (1.f / DH) + RMS_EPS);
        const f32x4 g0 = *(const f32x4*)(gat + 8 * lane), g1 = *(const f32x4*)(gat + 8 * lane + 4);
        u32x4 o; o.x = cvt_pk_bf16(w[0] * rstd2 * g0.x, w[1] * rstd2 * g0.y); o.y = cvt_pk_bf16(w[2] * rstd2 * g0.z, w[3] * rstd2 * g0.w);
        o.z = cvt_pk_bf16(w[4] * rstd2 * g1.x, w[5] * rstd2 * g1.y); o.w = cvt_pk_bf16(w[6] * rstd2 * g1.z, w[7] * rstd2 * g1.w);
        *(u32x4*)(Y + (size_t)mrow * D + DH + 8 * lane) = o;
    }
}

__global__ void __launch_bounds__(NWAVES * 64, 2) fwd_kernel(Params p) {
    extern __shared__ __attribute__((aligned(16))) unsigned char lds_raw[];
    LAS unsigned char* lds = (LAS unsigned char*)lds_raw;
    cg::grid_group grid = cg::this_grid();
    const int tid = threadIdx.x, lane = tid & 63, wave = __builtin_amdgcn_readfirstlane(tid >> 6);
    const int G = gridDim.x, bx = blockIdx.x;
    const int gw = bx * NWAVES + wave, NGW = G * NWAVES;
    unsigned char* ws = p.ws;
    bf16* W1A = (bf16*)(ws + WS_W1A); bf16* W1D = (bf16*)(ws + WS_W1D); bf16* WIN = (bf16*)(ws + WS_WIN); bf16* WOUT = (bf16*)(ws + WS_WOUT);
    bf16* W2A = (bf16*)(ws + WS_W2A); bf16* W2D = (bf16*)(ws + WS_W2D); bf16* XN = (bf16*)(ws + WS_XN); bf16* HB = (bf16*)(ws + WS_H);
    bf16* PT = (bf16*)(ws + WS_PT); bf16* QKV = (bf16*)(ws + WS_QKV); bf16* Y = (bf16*)(ws + WS_Y);

    {
        LAS float* scr = (LAS float*)(lds + wave * 16384);
        constexpr int I_UP = 16 * 88, I_DN = 44 * 32, I_IN = 16 * 96, I_OUT = 16 * 32;
        constexpr int NITEMS = 2 * (2 * I_UP + I_DN) + I_IN + I_OUT;
        for (int it = gw; it < NITEMS; it += NGW) {
            int r = it;
            if (r < I_UP) { p0_transpose_mat(p.in[I_WG1], D, FF, W1A, 1, r, scr, lane); continue; } r -= I_UP;
            if (r < I_UP) { p0_transpose_mat(p.in[I_WU1], D, FF, W1A, 2, r, scr, lane); continue; } r -= I_UP;
            if (r < I_DN) { p0_transpose_mat(p.in[I_WD1], FF, D, W1D, 0, r, scr, lane); continue; } r -= I_DN;
            if (r < I_UP) { p0_transpose_mat(p.in[I_WG2], D, FF, W2A, 1, r, scr, lane); continue; } r -= I_UP;
            if (r < I_UP) { p0_transpose_mat(p.in[I_WU2], D, FF, W2A, 2, r, scr, lane); continue; } r -= I_UP;
            if (r < I_DN) { p0_transpose_mat(p.in[I_WD2], FF, D, W2D, 0, r, scr, lane); continue; } r -= I_DN;
            if (r < I_IN) { p0_transpose_mat(p.in[I_WIN], D, 3072, WIN, 0, r, scr, lane); continue; } r -= I_IN;
            p0_transpose_mat(p.in[I_WOUT], D, D, WOUT, 0, r, scr, lane);
        }
        for (int m = gw; m < M; m += NGW) rms_row_to_bf16(p.in[I_X] + (size_t)m * D, p.in[I_G1], XN + (size_t)m * D, lane);
        __syncthreads();
        filt_stage1(p, lds, tid);
    }
    grid.sync();
    filt_stage2(p, lds, tid);
    {
        pg8::Gemm g{XN, W1A, M, 2 * FF, D, nullptr, nullptr}; pg8::StaticOrder S; S.init(M, 2 * FF, G, bx);
        pg8::EpiSwiglu E{HB, FF};
        pg8::gemm_phase<pg8::EpiSwiglu, pg8::StaticOrder, true, true>(lds, g, S, E);
    }
    grid.sync();
    {
        pg8::Gemm g{HB, W1D, M, D, FF, nullptr, nullptr}; pg8::StaticOrder S; S.init(M, D, G, bx);
        pg8::EpiResid E{p.in[I_X], p.out, D, 0.5f};
        pg8::gemm_phase<pg8::EpiResid, pg8::StaticOrder, true, true>(lds, g, S, E);
    }
    grid.sync();
    for (int m = gw; m < M; m += NGW) rms_row_to_bf16(p.out + (size_t)m * D, p.in[I_GMIX], XN + (size_t)m * D, lane);
    grid.sync();
    {
        pg8::Gemm g{WIN, XN, 0, 0, D, XN, WIN + (size_t)NQKV * D}; pg8::WinOrder S; S.init(G, bx);
        pg8::EpiStore2 E{PT, M, QKV, NQKV};
        pg8::gemm_phase<pg8::EpiStore2, pg8::WinOrder, true, true>(lds, g, S, E);
    }
    grid.sync();
    for (int c = bx; c < DH; c += G) conv_unit_scalar(p, lds, c, tid);
    __syncthreads();
    for (int it = gw; it < 8192; it += NGW) attn_item(p, lds + wave * ATT_WAVE_LDS, it, lane);
    grid.sync();
    for (int u = bx; u < M / 64; u += G) mixnorm_unit(p, lds, u, tid);
    __syncthreads();
    grid.sync();
    {
        pg8::Gemm g{Y, WOUT, M, D, D, nullptr, nullptr}; pg8::StaticOrder S; S.init(M, D, G, bx);
        pg8::EpiResid E{p.out, p.out, D, 1.0f};
        pg8::gemm_phase<pg8::EpiResid, pg8::StaticOrder, true, true>(lds, g, S, E);
    }
    grid.sync();
    for (int m = gw; m < M; m += NGW) rms_row_to_bf16(p.out + (size_t)m * D, p.in[I_G2], XN + (size_t)m * D, lane);
    grid.sync();
    {
        pg8::Gemm g{XN, W2A, M, 2 * FF, D, nullptr, nullptr}; pg8::StaticOrder S; S.init(M, 2 * FF, G, bx);
        pg8::EpiSwiglu E{HB, FF};
        pg8::gemm_phase<pg8::EpiSwiglu, pg8::StaticOrder, true, true>(lds, g, S, E);
    }
    grid.sync();
    {
        pg8::Gemm g{HB, W2D, M, D, FF, nullptr, nullptr}; pg8::StaticOrder S; S.init(M, D, G, bx);
        pg8::EpiResid E{p.out, p.out, D, 0.5f};
        pg8::gemm_phase<pg8::EpiResid, pg8::StaticOrder, true, true>(lds, g, S, E);
    }
    grid.sync();
    for (int m = gw; m < M; m += NGW) rms_row_to_f32(p.out + (size_t)m * D, p.in[I_GFIN], p.out + (size_t)m * D, lane);
}

extern "C" void kernel_launch(void* const* d_in, const int* in_sizes, int n_in, void* d_out, int out_size, void* d_ws, size_t ws_size, hipStream_t stream) {
    static int grid = 0;
    if (grid == 0) {
        if (n_in != 26 || in_sizes[0] != M * D || out_size != M * D || ws_size < WS_END) { fprintf(stderr, "kernel_launch: unexpected shapes (n_in %d, in0 %d, out %d, ws %zu)\n", n_in, n_in > 0 ? in_sizes[0] : -1, out_size, ws_size); grid = -1; return; }
        int dev = 0, cus = 0, per_cu = 0;
        hipGetDevice(&dev); hipDeviceGetAttribute(&cus, hipDeviceAttributeMultiprocessorCount, dev);
        if (hipFuncSetAttribute((const void*)fwd_kernel, hipFuncAttributeMaxDynamicSharedMemorySize, LDS_BYTES) != hipSuccess) { fprintf(stderr, "kernel_launch: hipFuncSetAttribute failed\n"); grid = -1; return; }
        if (hipOccupancyMaxActiveBlocksPerMultiprocessor(&per_cu, (const void*)fwd_kernel, NWAVES * 64, LDS_BYTES) != hipSuccess || per_cu < 1) { fprintf(stderr, "kernel_launch: occupancy query says %d blocks per CU\n", per_cu); (void)hipGetLastError(); grid = -1; return; }
        grid = cus;
    }
    if (grid < 0) return;
    Params prm{};
    for (int i = 0; i < 26; ++i) prm.in[i] = (const float*)d_in[i];
    prm.out = (float*)d_out; prm.ws = (unsigned char*)d_ws;
    void* args[] = {&prm};
    hipError_t e = hipLaunchCooperativeKernel((const void*)fwd_kernel, dim3(grid), dim3(NWAVES * 64), args, LDS_BYTES, stream);
    if (e != hipSuccess) fprintf(stderr, "kernel_launch: cooperative launch failed: %s (grid %d)\n", hipGetErrorString(e), grid);
}
```

```cpp
#include <hip/hip_runtime.h>
#include <hip/hip_cooperative_groups.h>
#include <cstdio>
#include <cstdint>
namespace cg = cooperative_groups;
namespace pg8 {
#define PG8_LAS __attribute__((address_space(3)))
typedef unsigned short bf16_t;
typedef short bf16x8 __attribute__((ext_vector_type(8)));
typedef float f32x4 __attribute__((ext_vector_type(4)));
typedef unsigned u32x4 __attribute__((ext_vector_type(4)));
constexpr int BM = 256, BK = 64, HALF = 128, HTB = HALF * BK * 2  , STAGE_BYTES = 8 * HTB, NXCD = 8, WGM = 8;

__host__ __device__ __forceinline__ int lds_byte(int r, int c) { const int st = (r >> 4) * 2 + (c >> 5), rr = r & 15, cc = c & 31, ob = rr * 64 + cc * 2; return st * 1024 + (ob ^ (((ob >> 9) & 1) << 5)); }
__host__ __device__ __forceinline__ void stage_rc(int b, int& R, int& C) { const int st = b / 1024, sb = b % 1024, swz = sb ^ (((sb >> 9) & 1) << 5); R = (st >> 1) * 16 + swz / 64; C = (st & 1) * 32 + (swz % 64) / 2; }
__host__ __device__ __forceinline__ int perm32(int rho) { const int n = rho >> 4, i = rho & 15; return 8 * (i >> 2) + 4 * n + (i & 3); }

struct Unit { int pm, pn, z; };
struct Gemm { const bf16_t* A; const bf16_t* Bt; int M, N, K; const bf16_t* A2; const bf16_t* Bt2; };

struct StaticOrder {
    int nM, nN, nwg, G, c;
    __host__ __device__ void init(int M, int N, int G_, int c_) { nM = M / BM; nN = N / BM; nwg = nM * nN; G = G_; c = c_; }
    __host__ __device__ bool next(int i, Unit& u) const {
        const long L = (long)i * G + c; if (L >= nwg) return false;
        int wgid = (int)L; { const int q = nwg / NXCD, r = nwg % NXCD, xcd = wgid % NXCD, off = wgid / NXCD; wgid = (xcd < r ? xcd * (q + 1) : r * (q + 1) + (xcd - r) * q) + off; }
        const int nig = WGM * nN, gid = wgid / nig, fm = gid * WGM, gsz = (nM - fm) < WGM ? (nM - fm) : WGM;
        u.pm = fm + ((wgid % nig) % gsz); u.pn = (wgid % nig) / gsz; u.z = 0; return true;
    }
    __device__ __forceinline__ void a_ready(const Unit&) const {}
    __device__ __forceinline__ void done(const Unit&) const {}
};

__device__ __forceinline__ unsigned cvt_pk_bf16(float lo, float hi) { unsigned r; asm volatile("v_cvt_pk_bf16_f32 %0, %1, %2" : "=v"(r) : "v"(lo), "v"(hi)); return r; }
typedef float f32x2 __attribute__((ext_vector_type(2)));
__device__ __forceinline__ f32x2 gelu_pk(f32x2 v) {
    const f32x2 av = __builtin_elementwise_abs(v), d = av * 0.2316418882f + 1.0f;
    f32x2 t; t.x = __builtin_amdgcn_rcpf(d.x); t.y = __builtin_amdgcn_rcpf(d.y);
    f32x2 q = t * 0.5307027145f + (-0.7265760135f); q = q * t + 0.7107068705f; q = q * t + (-0.142248368f); q = q * t + 0.127414796f; q = q * t;
    const f32x2 s = (v * v) * (-0.72134752044f);
    f32x2 e; e.x = __builtin_amdgcn_exp2f(s.x); e.y = __builtin_amdgcn_exp2f(s.y);
    const f32x2 m = v * (q * e), r = v - m;
    f32x2 o; o.x = v.x < 0.f ? m.x : r.x; o.y = v.y < 0.f ? m.y : r.y; return o;
}

struct EpiSwiglu {
    static constexpr bool PERM = true, AFTER_DRAIN = false;
    bf16_t* H; int ldh;
    __device__ __forceinline__ void operator()(const f32x4 (&acc)[2][2][4][2], const Unit& u, int wr, int wc, int fr, int fq) const {
        const int row0 = u.pm * BM + wr * 64 + fr, col0 = u.pn * HALF + wc * 32 + 8 * fq;
#pragma unroll
        for (int ai = 0; ai < 2; ++ai)
#pragma unroll
            for (int m = 0; m < 4; ++m) { bf16_t* rowp = H + (size_t)(row0 + ai * HALF + m * 16) * ldh + col0;
                float o[8];
#pragma unroll
                for (int n = 0; n < 2; ++n)
#pragma unroll
                    for (int e = 0; e < 4; ++e) { const float g = acc[ai][0][m][n][e], up = acc[ai][1][m][n][e];
                        const float sg = g * __builtin_amdgcn_rcpf(1.0f + __builtin_amdgcn_exp2f(-1.4426950408889634f * g)); o[n * 4 + e] = sg * up; }
                u32x4 w; w.x = cvt_pk_bf16(o[0], o[1]); w.y = cvt_pk_bf16(o[2], o[3]); w.z = cvt_pk_bf16(o[4], o[5]); w.w = cvt_pk_bf16(o[6], o[7]);
                *(u32x4*)rowp = w; }
    }
};
struct EpiResid {
    static constexpr bool PERM = false, AFTER_DRAIN = false;
    const float* base; float* out; int ldc; float scale;
    __device__ __forceinline__ void operator()(const f32x4 (&acc)[2][2][4][2], const Unit& u, int wr, int wc, int fr, int fq) const {
        const int row0 = u.pm * BM + wr * 64 + fr, col0 = u.pn * BM + wc * 32 + 4 * fq;
#pragma unroll
        for (int ai = 0; ai < 2; ++ai)
#pragma unroll
            for (int m = 0; m < 4; ++m) { const size_t off = (size_t)(row0 + ai * HALF + m * 16) * ldc + col0;
#pragma unroll
                for (int bj = 0; bj < 2; ++bj)
#pragma unroll
                    for (int n = 0; n < 2; ++n) { const f32x4 bs = *(const f32x4*)(base + off + bj * HALF + n * 16);
                        *(f32x4*)(out + off + bj * HALF + n * 16) = bs + acc[ai][bj][m][n] * scale; } }
    }
};
struct EpiStore2 {
    static constexpr bool PERM = true, AFTER_DRAIN = false;
    bf16_t* O0; int ld0; bf16_t* O1; int ld1;
    __device__ __forceinline__ void operator()(const f32x4 (&acc)[2][2][4][2], const Unit& u, int wr, int wc, int fr, int fq) const {
        bf16_t* O = u.z ? O1 : O0; const int ldc = u.z ? ld1 : ld0;
        const int row0 = u.pm * BM + wr * 64 + fr, col0 = u.pn * BM + wc * 32 + 8 * fq;
#pragma unroll
        for (int ai = 0; ai < 2; ++ai)
#pragma unroll
            for (int m = 0; m < 4; ++m) { bf16_t* rowp = O + (size_t)(row0 + ai * HALF + m * 16) * ldc + col0;
#pragma unroll
                for (int bj = 0; bj < 2; ++bj) { const f32x4 v0 = acc[ai][bj][m][0], v1 = acc[ai][bj][m][1];
                    u32x4 w; w.x = cvt_pk_bf16(v0[0], v0[1]); w.y = cvt_pk_bf16(v0[2], v0[3]); w.z = cvt_pk_bf16(v1[0], v1[1]); w.w = cvt_pk_bf16(v1[2], v1[3]);
                    *(u32x4*)(rowp + bj * HALF) = w; } }
    }
};
struct WinOrder {
    StaticOrder so;
    __host__ __device__ void init(int G_, int c_) { so.init(64 * BM, 12 * BM, G_, c_); }
    __host__ __device__ bool next(int i, Unit& u) const {
        Unit v; if (!so.next(i, v)) return false;
        if (v.pn < 6) { u.pm = v.pn; u.pn = v.pm; u.z = 0; } else { u.pm = v.pm; u.pn = v.pn - 6; u.z = 1; }
        return true;
    }
    __device__ __forceinline__ void a_ready(const Unit&) const {}
    __device__ __forceinline__ void done(const Unit&) const {}
};
template <class Epi, class Sched, bool ALIGN_EPI = false, bool SP2 = false>
__device__ __forceinline__ void gemm_phase(PG8_LAS unsigned char* lds, const Gemm g, const Sched& S, const Epi& E) {
    int tid_ = threadIdx.x; asm volatile("" : "+v"(tid_));
    const int tid = tid_, wid = __builtin_amdgcn_readfirstlane(tid >> 6), lane = tid & 63, wr = wid >> 2, wc = wid & 3, fr = lane & 15, fq = lane >> 4;
    const int K = g.K, nt = K / BK;
    unsigned voffA[2], voffB[2];
#pragma unroll
    for (int i = 0; i < 2; ++i) { int R, C; stage_rc(tid * 16 + i * 8192, R, C); const int Rb = Epi::PERM ? ((R & ~31) + perm32(R & 31)) : R;
        voffA[i] = (unsigned)(R * K + C) * 2u; voffB[i] = (unsigned)(Rb * K + C) * 2u; }
    const size_t kstep = (size_t)(BK * 2);
    const size_t hstep = (size_t)HALF * K * 2;
    const size_t tstep = 2 * hstep;
    const unsigned ldsw = (unsigned)wid * 1024u;
    const int aoff = lds_byte(wr * 64 + fr, fq * 8), boff = lds_byte(wc * 32 + fr, fq * 8);
#define PG8_SA(b, h) (((b) * 2 + (h)) * HTB)
#define PG8_SB(b, h) ((4 + (b) * 2 + (h)) * HTB)
#define PG8_STAGE(bufoff, gbase, voff) do { _Pragma("unroll") for (int _i = 0; _i < 2; ++_i) \
        __builtin_amdgcn_global_load_lds((const unsigned*)((const char*)(gbase) + (voff)[_i]), (PG8_LAS unsigned*)(lds + (bufoff) + ldsw + _i * 8192), 16, 0, 0); } while (0)
#define PG8_LDA(dst, b, h) do { _Pragma("unroll") for (int m = 0; m < 4; ++m) _Pragma("unroll") for (int k = 0; k < 2; ++k) dst[m][k] = *(const PG8_LAS bf16x8*)(lds + PG8_SA(b, h) + aoff + m * 2048 + k * 1024); } while (0)
#define PG8_LDB(dst, b, h) do { _Pragma("unroll") for (int n = 0; n < 2; ++n) _Pragma("unroll") for (int k = 0; k < 2; ++k) dst[n][k] = *(const PG8_LAS bf16x8*)(lds + PG8_SB(b, h) + boff + n * 2048 + k * 1024); } while (0)
#define PG8_MMA(ai, bj, At, Bt) do { __builtin_amdgcn_s_setprio(1); _Pragma("unroll") for (int m = 0; m < 4; ++m) _Pragma("unroll") for (int n = 0; n < 2; ++n) _Pragma("unroll") for (int k = 0; k < 2; ++k) \
        acc[ai][bj][m][n] = __builtin_amdgcn_mfma_f32_16x16x32_bf16(Bt[n][k], At[m][k], acc[ai][bj][m][n], 0, 0, 0); __builtin_amdgcn_s_setprio(0); } while (0)
#define PG8_WAIT_V(n) asm volatile("s_waitcnt vmcnt(" #n ")" ::: "memory")
#define PG8_WAIT_L(n) asm volatile("s_waitcnt lgkmcnt(" #n ")" ::: "memory")
#define PG8_BAR __builtin_amdgcn_s_barrier()
#define PG8_SCHED __builtin_amdgcn_sched_barrier(0)
    Unit cur, nxt; int ui = 0;
    if (!S.next(0, cur)) return;
    f32x4 acc[2][2][4][2];
#pragma unroll
    for (int a = 0; a < 2; ++a)
#pragma unroll
        for (int b = 0; b < 2; ++b)
#pragma unroll
            for (int m = 0; m < 4; ++m)
#pragma unroll
                for (int n = 0; n < 2; ++n) acc[a][b][m][n] = (f32x4){0.f, 0.f, 0.f, 0.f};
    bf16x8 At[4][2], B0[2][2], B1[2][2];
    const char* cA = (const char*)(cur.z ? g.A2 : g.A) + (size_t)cur.pm * tstep; const char* cB = (const char*)(cur.z ? g.Bt2 : g.Bt) + (size_t)cur.pn * tstep;
    S.a_ready(cur);
    if constexpr (SP2) {
        PG8_STAGE(PG8_SB(0, 0), cB, voffB); PG8_STAGE(PG8_SB(0, 1), cB + hstep, voffB); PG8_STAGE(PG8_SA(0, 0), cA, voffA); PG8_STAGE(PG8_SA(0, 1), cA + hstep, voffA);
        if (wr == 1) PG8_BAR;
        PG8_WAIT_V(2); PG8_BAR;
        PG8_STAGE(PG8_SB(1, 0), cB + kstep, voffB); PG8_STAGE(PG8_SA(1, 0), cA + kstep, voffA); PG8_STAGE(PG8_SB(1, 1), cB + hstep + kstep, voffB);
        PG8_WAIT_V(6); PG8_BAR;
    } else {
        PG8_STAGE(PG8_SB(0, 0), cB, voffB); PG8_STAGE(PG8_SA(0, 0), cA, voffA); PG8_STAGE(PG8_SB(0, 1), cB + hstep, voffB); PG8_STAGE(PG8_SA(0, 1), cA + hstep, voffA);
        if (wr == 1) PG8_BAR;
        PG8_WAIT_V(4); PG8_BAR;
        PG8_STAGE(PG8_SB(1, 0), cB + kstep, voffB); PG8_STAGE(PG8_SA(1, 0), cA + kstep, voffA); PG8_STAGE(PG8_SB(1, 1), cB + hstep + kstep, voffB);
        PG8_WAIT_V(6); PG8_BAR;
    }
    for (;;) {
        const bool has_next = S.next(ui + 1, nxt);
        const char* nA = has_next ? (const char*)(nxt.z ? g.A2 : g.A) + (size_t)nxt.pm * tstep : cA; const char* nB = has_next ? (const char*)(nxt.z ? g.Bt2 : g.Bt) + (size_t)nxt.pn * tstep : cB;
        for (int t = 0; t < nt; t += 2) {
            const bool last = (t == nt - 2);
            const char* a1 = cA + (size_t)(t + 1) * kstep;
            const char* a2 = last ? nA : cA + (size_t)(t + 2) * kstep; const char* b2 = last ? nB : cB + (size_t)(t + 2) * kstep;
            const char* a3 = a2 + kstep; const char* b3 = b2 + kstep;
            if (last && has_next) S.a_ready(nxt);
            if constexpr (SP2) {
            PG8_LDB(B0, 0, 0); PG8_LDB(B1, 0, 1); PG8_SCHED; PG8_LDA(At, 0, 0); PG8_STAGE(PG8_SA(1, 1), a1 + hstep, voffA);
            PG8_WAIT_V(8); PG8_WAIT_L(0); PG8_BAR; PG8_MMA(0, 0, At, B0); PG8_MMA(0, 1, At, B1); PG8_BAR; PG8_SCHED;
            PG8_LDA(At, 0, 1); PG8_STAGE(PG8_SB(0, 0), b2, voffB); PG8_STAGE(PG8_SB(0, 1), b2 + hstep, voffB); PG8_STAGE(PG8_SA(0, 0), a2, voffA);
            PG8_WAIT_V(8); PG8_WAIT_L(0); PG8_BAR; PG8_MMA(1, 0, At, B0); PG8_MMA(1, 1, At, B1); PG8_BAR; PG8_SCHED;
            PG8_LDB(B0, 1, 0); PG8_LDB(B1, 1, 1); PG8_SCHED; PG8_LDA(At, 1, 0); PG8_STAGE(PG8_SA(0, 1), a2 + hstep, voffA);
            PG8_WAIT_V(8); PG8_WAIT_L(0); PG8_BAR; PG8_MMA(0, 0, At, B0); PG8_MMA(0, 1, At, B1); PG8_BAR; PG8_SCHED;
            PG8_LDA(At, 1, 1); PG8_STAGE(PG8_SB(1, 0), b3, voffB); PG8_STAGE(PG8_SB(1, 1), b3 + hstep, voffB); PG8_STAGE(PG8_SA(1, 0), a3, voffA);
            PG8_WAIT_V(8); PG8_WAIT_L(0); PG8_BAR; PG8_MMA(1, 0, At, B0); PG8_MMA(1, 1, At, B1); PG8_BAR; PG8_SCHED;
            } else {
            PG8_LDB(B0, 0, 0); PG8_SCHED; PG8_LDA(At, 0, 0); PG8_STAGE(PG8_SA(1, 1), a1 + hstep, voffA);
            PG8_WAIT_L(8); PG8_BAR; PG8_WAIT_L(0); PG8_MMA(0, 0, At, B0); PG8_BAR; PG8_SCHED;
            PG8_LDB(B1, 0, 1); PG8_STAGE(PG8_SB(0, 0), b2, voffB);
            PG8_BAR; PG8_WAIT_L(0); PG8_MMA(0, 1, At, B1); PG8_BAR;
            PG8_LDA(At, 0, 1); PG8_STAGE(PG8_SA(0, 0), a2, voffA);
            PG8_BAR; PG8_WAIT_L(0); PG8_MMA(1, 0, At, B0); PG8_BAR; PG8_SCHED;
            PG8_STAGE(PG8_SB(0, 1), b2 + hstep, voffB);
            PG8_WAIT_V(6); PG8_BAR; PG8_MMA(1, 1, At, B1); PG8_BAR;
            PG8_LDB(B0, 1, 0); PG8_SCHED; PG8_LDA(At, 1, 0); PG8_STAGE(PG8_SA(0, 1), a2 + hstep, voffA);
            PG8_WAIT_L(8); PG8_BAR; PG8_WAIT_L(0); PG8_MMA(0, 0, At, B0); PG8_BAR; PG8_SCHED;
            PG8_LDB(B1, 1, 1); PG8_STAGE(PG8_SB(1, 0), b3, voffB);
            PG8_BAR; PG8_WAIT_L(0); PG8_MMA(0, 1, At, B1); PG8_BAR;
            PG8_LDA(At, 1, 1); PG8_STAGE(PG8_SA(1, 0), a3, voffA);
            PG8_BAR; PG8_WAIT_L(0); PG8_MMA(1, 0, At, B0); PG8_BAR; PG8_SCHED;
            PG8_STAGE(PG8_SB(1, 1), b3 + hstep, voffB);
            PG8_WAIT_V(6); PG8_BAR; PG8_MMA(1, 1, At, B1); PG8_BAR;
            }
        }
        if constexpr (ALIGN_EPI) { if (wr == 0) PG8_BAR; }
        if constexpr (!Epi::AFTER_DRAIN) { E(acc, cur, wr, wc, fr, fq); S.done(cur); }
        if (!has_next) break;
#pragma unroll
        for (int a = 0; a < 2; ++a)
#pragma unroll
            for (int b = 0; b < 2; ++b)
#pragma unroll
                for (int m = 0; m < 4; ++m)
#pragma unroll
                    for (int n = 0; n < 2; ++n) acc[a][b][m][n] = (f32x4){0.f, 0.f, 0.f, 0.f};
        cur = nxt; cA = nA; cB = nB; ++ui;
        if constexpr (ALIGN_EPI) { if (wr == 1) PG8_BAR; }
    }
    PG8_WAIT_V(0);
    if constexpr (!ALIGN_EPI) { if (wr == 0) PG8_BAR; }
    PG8_BAR;
    if constexpr (Epi::AFTER_DRAIN) { E.fused(acc, cur, wr, wc, fr, fq, lds, wid, lane); S.done(cur); }
#undef PG8_SA
#undef PG8_SB
#undef PG8_STAGE
#undef PG8_LDA
#undef PG8_LDB
#undef PG8_MMA
#undef PG8_WAIT_V
#undef PG8_WAIT_L
#undef PG8_BAR
#undef PG8_SCHED
}
}
constexpr int NWAVES = 8;
constexpr int M = 16384, D = 1024, FF = 2816, NBATCH = 8, SEQ = 2048, DH = 512, NQKV = 1536;
constexpr float RMS_EPS = 1e-6f;
constexpr int LDS_BYTES = 147456;
constexpr size_t MiB = 1u << 20;
constexpr size_t WS_W1A = 0, WS_W1D = 11 * MiB, WS_WIN = 17 * MiB, WS_WOUT = 23 * MiB, WS_W2A = 25 * MiB, WS_W2D = 36 * MiB;
constexpr size_t WS_XN = 42 * MiB;
constexpr size_t WS_H = 74 * MiB;
constexpr size_t WS_PT = 74 * MiB;
constexpr size_t WS_QKV = 122 * MiB;
constexpr size_t WS_YHT = 170 * MiB;
constexpr size_t WS_YA = 186 * MiB;
constexpr size_t WS_Y = 202 * MiB;
constexpr size_t WS_G = 234 * MiB;
constexpr size_t WS_H3 = 242 * MiB;
constexpr size_t WS_END = 243 * MiB;

#define LAS __attribute__((address_space(3)))
typedef unsigned short bf16;
typedef float f32x4 __attribute__((ext_vector_type(4)));
typedef unsigned u32x4 __attribute__((ext_vector_type(4)));
typedef unsigned u32x2 __attribute__((ext_vector_type(2)));
typedef short bf16x8 __attribute__((ext_vector_type(8)));
typedef short s16x4 __attribute__((ext_vector_type(4)));
#define LDS_WAIT() asm volatile("s_waitcnt lgkmcnt(0)" ::: "memory")
using pg8::cvt_pk_bf16;
__device__ __forceinline__ float bf2f(unsigned v) { return __uint_as_float(v << 16); }
__device__ __forceinline__ unsigned f2bf(float f) { return cvt_pk_bf16(f, 0.f) & 0xffffu; }
__device__ __forceinline__ float wave_sum(float v) {
#pragma unroll
    for (int o = 1; o < 64; o <<= 1) v += __shfl_xor(v, o);
    return v;
}

struct Params { const float* in[26]; float* out; unsigned char* ws; };
enum { I_X = 0, I_G1, I_WG1, I_WU1, I_WD1, I_GMIX, I_WIN, I_CW, I_CB, I_FW1, I_FB1, I_FW2, I_FB2, I_FW3, I_FB3, I_FWO, I_FREQ, I_SKIP, I_GHY, I_GAT, I_WOUT, I_G2, I_WG2, I_WU2, I_WD2, I_GFIN };

__device__ __forceinline__ void p0_transpose_item(const float* W, int K, int N, bf16* WT, int k0, int n0, int drow0, LAS float* scr, int lane) {
#pragma unroll 8
    for (int i = 0; i < 32; ++i) { const int kk = 2 * i + (lane >> 5); scr[kk * 33 + (lane & 31)] = W[(size_t)(k0 + kk) * N + n0 + (lane & 31)]; }
    LDS_WAIT();
    const int c = lane & 7;
#pragma unroll
    for (int j = 0; j < 4; ++j) { const int n = (lane >> 3) + 8 * j; const LAS float* s = scr + (8 * c) * 33 + n;
        u32x4 o; o.x = cvt_pk_bf16(s[0 * 33], s[1 * 33]); o.y = cvt_pk_bf16(s[2 * 33], s[3 * 33]); o.z = cvt_pk_bf16(s[4 * 33], s[5 * 33]); o.w = cvt_pk_bf16(s[6 * 33], s[7 * 33]);
        *(u32x4*)(WT + (size_t)(drow0 + n) * K + k0 + 8 * c) = o; }
    LDS_WAIT();
}
__device__ __forceinline__ void p0_transpose_mat(const float* W, int K, int N, bf16* WT, int mode, int item, LAS float* scr, int lane) {
    const int nblk = N / 32, kb = item / nblk, nb = item % nblk, n0 = 32 * nb;
    const int drow0 = mode == 0 ? n0 : (256 * (n0 / 128) + (n0 % 128) + (mode == 2 ? 128 : 0));
    p0_transpose_item(W, K, N, WT, 64 * kb, n0, drow0, scr, lane);
}
__device__ __forceinline__ void rms_row_to_bf16(const float* xrow, const float* g, bf16* orow, int lane) {
    const f32x4* xr = (const f32x4*)xrow + lane; const f32x4* gr = (const f32x4*)g + lane;
    f32x4 v[4]; float s = 0.f;
#pragma unroll
    for (int j = 0; j < 4; ++j) { v[j] = xr[64 * j]; s += (v[j].x * v[j].x + v[j].y * v[j].y) + (v[j].z * v[j].z + v[j].w * v[j].w); }
    const float rstd = 1.0f / sqrtf(wave_sum(s) * (1.f / D) + RMS_EPS);
    u32x2* o8 = (u32x2*)orow + lane;
#pragma unroll
    for (int j = 0; j < 4; ++j) { const f32x4 gv = gr[64 * j]; u32x2 w; w.x = cvt_pk_bf16(v[j].x * rstd * gv.x, v[j].y * rstd * gv.y); w.y = cvt_pk_bf16(v[j].z * rstd * gv.z, v[j].w * rstd * gv.w); o8[64 * j] = w; }
}
__device__ __forceinline__ void rms_row_to_f32(const float* xrow, const float* g, float* orow, int lane) {
    const f32x4* xr = (const f32x4*)xrow + lane; const f32x4* gr = (const f32x4*)g + lane;
    f32x4 v[4]; float s = 0.f;
#pragma unroll
    for (int j = 0; j < 4; ++j) { v[j] = xr[64 * j]; s += (v[j].x * v[j].x + v[j].y * v[j].y) + (v[j].z * v[j].z + v[j].w * v[j].w); }
    const float rstd = 1.0f / sqrtf(wave_sum(s) * (1.f / D) + RMS_EPS);
    f32x4* o = (f32x4*)orow + lane;
#pragma unroll
    for (int j = 0; j < 4; ++j) { const f32x4 gv = gr[64 * j]; o[64 * j] = v[j] * rstd * gv; }
}

__device__ __forceinline__ void filt_stage1(const Params& p, LAS unsigned char* lds, int tid) {
    const int wave = tid >> 6, j = tid & 63;
    LAS float* zb = (LAS float*)lds + wave * 192; LAS float* ha = zb + 64; LAS float* hb = zb + 128;
    LAS float* w1l = (LAS float*)(lds + 8192); LAS float* w2l = w1l + 33 * 64; LAS float* w3l = w2l + 64 * 64;
    float* H3 = (float*)(p.ws + WS_H3);
    for (int i = tid; i < 33 * 64; i += NWAVES * 64) w1l[i] = p.in[I_FW1][i];
    for (int i = tid; i < 64 * 64; i += NWAVES * 64) { w2l[i] = p.in[I_FW2][i]; w3l[i] = p.in[I_FW3][i]; }
    const float fq = p.in[I_FREQ][j], b1 = p.in[I_FB1][j], b2 = p.in[I_FB2][j], b3 = p.in[I_FB3][j];
    __syncthreads();
    for (int base = blockIdx.x * 8; base < SEQ; base += gridDim.x * 8) {
        const int pos = base + wave;
        const float tl = (float)pos / 2047.0f, w = (6.283185307179586f * (float)pos) / 2048.0f;
        if (j < 33) { float z; if (j == 0) z = tl; else { const int i = (j - 1) & 15; const float f = 1e-4f + (float)i * ((15.0f - 1e-4f) / 15.0f); z = (j <= 16) ? cosf(f * w) : -sinf(f * w); } zb[j] = z; }
        __syncthreads();
        { float a = b1;
#pragma unroll
          for (int i = 0; i < 33; ++i) a += zb[i] * w1l[i * 64 + j];
          ha[j] = sinf(fq * a); }
        __syncthreads();
        { float a = b2;
#pragma unroll
          for (int i = 0; i < 64; ++i) a += ha[i] * w2l[i * 64 + j];
          hb[j] = sinf(fq * a); }
        __syncthreads();
        { float a = b3;
#pragma unroll
          for (int i = 0; i < 64; ++i) a += hb[i] * w3l[i * 64 + j];
          H3[pos * 64 + j] = sinf(fq * a); }
        __syncthreads();
    }
}
__device__ __forceinline__ void filt_stage2(const Params& p, LAS unsigned char* lds, int tid) {
    LAS float* wl = (LAS float*)lds;
    const float* H3 = (const float*)(p.ws + WS_H3); bf16* G = (bf16*)(p.ws + WS_G);
    const int e = tid & 7, ps = tid >> 3;
    for (int cb = blockIdx.x; cb < 256; cb += gridDim.x) {
        const int col = 8 * cb + e, o = col >> 10, dir = (col >> 9) & 1, c = col & 511;
        __syncthreads();
        wl[(tid & 7) * 64 + (tid >> 3)] = p.in[I_FWO][(size_t)(tid >> 3) * 2048 + 8 * cb + (tid & 7)];
        __syncthreads();
        const float ad = 3.0701134573253943f + (float)c * ((15.350567286626972f - 3.0701134573253943f) / 511.0f);
        bf16* gp = G + (size_t)(c * 2 + o) * 4096;
        const LAS f32x4* wv = (const LAS f32x4*)(wl + e * 64);
#pragma unroll 1
        for (int k = 0; k < 32; ++k) {
            const int pos = 64 * k + ps; const f32x4* hr = (const f32x4*)(H3 + (size_t)pos * 64);
            float acc = 0.f;
#pragma unroll
            for (int q = 0; q < 16; ++q) { const f32x4 hv = hr[q], w4 = wv[q]; acc += (hv.x * w4.x + hv.y * w4.y) + (hv.z * w4.z + hv.w * w4.w); }
            const float val = acc * expf(-((float)pos / 2047.0f) * ad);
            if (dir == 0) gp[2048 + pos] = (bf16)f2bf(val); else if (pos > 0) gp[2048 - pos] = (bf16)f2bf(val); else gp[0] = 0;
        }
    }
    __syncthreads();
}

__device__ __forceinline__ float sconv(const bf16* row, int t, float w0, float w1, float w2, float bias) {
    float a = bias + w1 * bf2f(row[t]);
    if (t > 0) a += w0 * bf2f(row[t - 1]);
    if (t < SEQ - 1) a += w2 * bf2f(row[t + 1]);
    return a;
}
__device__ __forceinline__ void conv_unit_scalar(const Params& p, LAS unsigned char* lds, int c, int tid) {
    LAS float* g = (LAS float*)lds;
    LAS bf16* zA = (LAS bf16*)(lds + 16384);
    LAS bf16* zB = (LAS bf16*)(lds + 16384 + 32768);
    const bf16* PT = (const bf16*)(p.ws + WS_PT); const bf16* G = (const bf16*)(p.ws + WS_G); bf16* YHT = (bf16*)(p.ws + WS_YHT);
    const float* cw = p.in[I_CW]; const float* cb = p.in[I_CB];
    float x1c[4][8], x2c[4][8];
    {
        const float v0 = cw[c], v1 = cw[1536 + c], v2 = cw[3072 + c], vb = cb[c];
        const float a0 = cw[512 + c], a1 = cw[1536 + 512 + c], a2 = cw[3072 + 512 + c], ab = cb[512 + c];
        const float b0 = cw[1024 + c], b1 = cw[1536 + 1024 + c], b2 = cw[3072 + 1024 + c], bb = cb[1024 + c];
#pragma unroll
        for (int k = 0; k < 4; ++k)
#pragma unroll
            for (int b = 0; b < 8; ++b) { const int t = tid + 512 * k;
                zA[b * 2048 + t] = (bf16)f2bf(sconv(PT + (size_t)c * M + b * SEQ, t, v0, v1, v2, vb));
                x1c[k][b] = sconv(PT + (size_t)(512 + c) * M + b * SEQ, t, a0, a1, a2, ab);
                x2c[k][b] = sconv(PT + (size_t)(1024 + c) * M + b * SEQ, t, b0, b1, b2, bb); }
    }
    for (int o = 0; o < 2; ++o) {
        __syncthreads();
#pragma unroll
        for (int e = 0; e < 8; ++e) { const int idx = tid + 512 * e; g[idx] = bf2f(G[(size_t)(c * 2 + o) * 4096 + idx]); }
        __syncthreads();
        const LAS bf16* zin = o ? zB : zA;
        float acc[4][8];
#pragma unroll
        for (int k = 0; k < 4; ++k)
#pragma unroll
            for (int b = 0; b < 8; ++b) acc[k][b] = 0.f;
        for (int s = 0; s < SEQ; ++s) {
            float zv[8];
#pragma unroll
            for (int b = 0; b < 8; ++b) zv[b] = bf2f(zin[b * 2048 + s]);
#pragma unroll
            for (int k = 0; k < 4; ++k) { const float gv = g[2048 + tid + 512 * k - s];
#pragma unroll
                for (int b = 0; b < 8; ++b) acc[k][b] += gv * zv[b]; }
        }
        const float skip = p.in[I_SKIP][o * 512 + c];
#pragma unroll
        for (int k = 0; k < 4; ++k)
#pragma unroll
            for (int b = 0; b < 8; ++b) { const int t = tid + 512 * k; const float y = acc[k][b] + bf2f(zin[b * 2048 + t]) * skip;
                if (o == 0) zB[b * 2048 + t] = (bf16)f2bf(x1c[k][b] * y); else YHT[(size_t)c * M + b * SEQ + t] = (bf16)f2bf(x2c[k][b] * y); }
    }
    __syncthreads();
}
constexpr int CV_GCS = 8224, CV_ZA = 8 * CV_GCS, CV_ZB = CV_ZA + 66 * 512, CV_R = CV_ZB + 66 * 512;
static_assert(CV_R + 8192 <= LDS_BYTES, "conv LDS map");
__device__ __forceinline__ void conv_build_gc(LAS unsigned char* lds, int tid) {
    const LAS bf16* R = (const LAS bf16*)(lds + CV_R);
#pragma unroll
    for (int s = 0; s < 8; ++s) {
        const int i0 = 4096 + s - 8 * tid; unsigned e[8];
#pragma unroll
        for (int jj = 0; jj < 8; ++jj) { const int idx = i0 - jj; e[jj] = (idx >= 1 && idx <= 4095) ? (unsigned)R[idx] : 0u; }
        u32x4 w; w.x = e[0] | (e[1] << 16); w.y = e[2] | (e[3] << 16); w.z = e[4] | (e[5] << 16); w.w = e[6] | (e[7] << 16);
        *(LAS u32x4*)(lds + s * CV_GCS + tid * 16) = w;
    }
}
__device__ __forceinline__ void conv_mma(LAS unsigned char* lds, int zoff, int wave, int lane, f32x4 (&acc)[4][2]) {
    const int fr = lane & 15, fq = lane >> 4;
    const LAS unsigned char* ab = lds + (fr & 7) * CV_GCS + (8 * fq - 8 * (fr >> 3) + 2048) * 2;
    const LAS unsigned char* zb = lds + zoff + (fr >> 3) * 512 + (fr & 7) * 64 + fq * 16 + 512;
#pragma unroll
    for (int jt = 0; jt < 4; ++jt) { acc[jt][0] = (f32x4){0.f, 0.f, 0.f, 0.f}; acc[jt][1] = (f32x4){0.f, 0.f, 0.f, 0.f}; }
    const int Dlo = 8 * wave - 63, Dhi = (8 * wave + 7) > 63 ? 63 : (8 * wave + 7);
#pragma unroll 2
    for (int D = Dlo; D <= Dhi; ++D) {
        const bf16x8 a0 = *(const LAS bf16x8*)(ab - 64 * D), a1 = *(const LAS bf16x8*)(ab - 64 * D - 32);
#pragma unroll
        for (int jt = 0; jt < 4; ++jt) { const int Q0 = 8 * wave + 2 * jt - D;
            if (Q0 >= -1 && Q0 <= 63) { const bf16x8 bv = *(const LAS bf16x8*)(zb + Q0 * 512);
                acc[jt][0] = __builtin_amdgcn_mfma_f32_16x16x32_bf16(a0, bv, acc[jt][0], 0, 0, 0);
                acc[jt][1] = __builtin_amdgcn_mfma_f32_16x16x32_bf16(a1, bv, acc[jt][1], 0, 0, 0); } }
    }
}
__device__ __forceinline__ f32x4 sconv4(const bf16* row, int t0, float w0, float w1, float w2, float bias) {
    const u32x2 v = *(const u32x2*)(row + t0);
    const float c0 = bf2f(v.x & 0xffffu), c1 = bf2f(v.x >> 16), c2 = bf2f(v.y & 0xffffu), c3 = bf2f(v.y >> 16);
    const float pm = (t0 & (SEQ - 1)) > 0 ? bf2f(row[t0 - 1]) : 0.f, pp = (t0 & (SEQ - 1)) + 4 < SEQ ? bf2f(row[t0 + 4]) : 0.f;
    f32x4 o; o.x = bias + w0 * pm + w1 * c0 + w2 * c1; o.y = bias + w0 * c0 + w1 * c1 + w2 * c2; o.z = bias + w0 * c1 + w1 * c2 + w2 * c3; o.w = bias + w0 * c2 + w1 * c3 + w2 * pp;
    return o;
}
__device__ __forceinline__ void conv_unit_mfma(const Params& p, LAS unsigned char* lds, int c, int tid) {
    const int lane = tid & 63, wave = __builtin_amdgcn_readfirstlane(tid >> 6), fr = lane & 15, fq = lane >> 4, nb = fr >> 3, b = fr & 7;
    const bf16* PT = (const bf16*)(p.ws + WS_PT); const bf16* G = (const bf16*)(p.ws + WS_G); bf16* YHT = (bf16*)(p.ws + WS_YHT);
    const float* cw = p.in[I_CW]; const float* cb = p.in[I_CB];
    __syncthreads();
    *(LAS u32x4*)(lds + CV_R + tid * 16) = *(const u32x4*)(G + (size_t)(c * 2) * 4096 + tid * 8);
    const u32x4 g1v = *(const u32x4*)(G + (size_t)(c * 2 + 1) * 4096 + tid * 8);
    if (tid < 128) { const int q = tid & 31, which = tid >> 5; unsigned zz; asm volatile("v_mov_b32 %0, 0" : "=v"(zz));
        *(LAS u32x4*)(lds + (which & 1 ? CV_ZB : CV_ZA) + (which & 2 ? 65 * 512 : 0) + q * 16) = (u32x4){zz, zz, zz, zz}; }
    f32x4 x1c[4][2], x2c[4][2];
    {
        const float v0 = cw[c], v1 = cw[1536 + c], v2 = cw[3072 + c], vb = cb[c];
        const float a0 = cw[512 + c], a1 = cw[1536 + 512 + c], a2 = cw[3072 + 512 + c], ab = cb[512 + c];
        const float b0 = cw[1024 + c], b1 = cw[1536 + 1024 + c], b2 = cw[3072 + 1024 + c], bb = cb[1024 + c];
#pragma unroll
        for (int jt = 0; jt < 4; ++jt)
#pragma unroll
            for (int h = 0; h < 2; ++h) { const int P = 8 * wave + 2 * jt + nb, t0 = 32 * P + 16 * h + 4 * fq;
                const f32x4 v = sconv4(PT + (size_t)c * M + b * SEQ, t0, v0, v1, v2, vb);
                u32x2 w; w.x = cvt_pk_bf16(v.x, v.y); w.y = cvt_pk_bf16(v.z, v.w);
                *(LAS u32x2*)(lds + CV_ZA + (P + 1) * 512 + b * 64 + (16 * h + 4 * fq) * 2) = w;
                x1c[jt][h] = sconv4(PT + (size_t)(512 + c) * M + b * SEQ, t0, a0, a1, a2, ab);
                x2c[jt][h] = sconv4(PT + (size_t)(1024 + c) * M + b * SEQ, t0, b0, b1, b2, bb); }
    }
    for (int o = 0; o < 2; ++o) {
        __syncthreads();
        if (o == 1) { *(LAS u32x4*)(lds + CV_R + tid * 16) = g1v; __syncthreads(); }
        conv_build_gc(lds, tid);
        __syncthreads();
        f32x4 acc[4][2];
        const int zoff = o ? CV_ZB : CV_ZA;
        conv_mma(lds, zoff, wave, lane, acc);
        const float skip = p.in[I_SKIP][o * 512 + c];
#pragma unroll
        for (int jt = 0; jt < 4; ++jt)
#pragma unroll
            for (int h = 0; h < 2; ++h) { const int P = 8 * wave + 2 * jt + nb, t0 = 32 * P + 16 * h + 4 * fq;
                const u32x2 zi = *(const LAS u32x2*)(lds + zoff + (P + 1) * 512 + b * 64 + (16 * h + 4 * fq) * 2);
                f32x4 y; y.x = acc[jt][h].x + bf2f(zi.x & 0xffffu) * skip; y.y = acc[jt][h].y + bf2f(zi.x >> 16) * skip; y.z = acc[jt][h].z + bf2f(zi.y & 0xffffu) * skip; y.w = acc[jt][h].w + bf2f(zi.y >> 16) * skip;
                const f32x4 gate = o ? x2c[jt][h] : x1c[jt][h]; y = y * gate;
                u32x2 w; w.x = cvt_pk_bf16(y.x, y.y); w.y = cvt_pk_bf16(y.z, y.w);
                if (o == 0) *(LAS u32x2*)(lds + CV_ZB + (P + 1) * 512 + b * 64 + (16 * h + 4 * fq) * 2) = w;
                else *(u32x2*)(YHT + (size_t)c * M + b * SEQ + t0) = w; }
    }
}
typedef short v4i16_t __attribute__((ext_vector_type(4)));
__device__ __forceinline__ s16x4 vtr(const LAS unsigned char* p) { return __builtin_bit_cast(s16x4, __builtin_amdgcn_ds_read_tr16_b64_v4i16((LAS v4i16_t*)p)); }
constexpr int ATT_VROW = 144;
constexpr int ATT_WAVE_LDS = 32 * ATT_VROW;
constexpr int ATT_NPAIR = 23;
__device__ __forceinline__ void att_pair_params(int pi, int tq0, int& st, int& kb) {
    if (pi < 5) { st = 16; kb = tq0 - 1024 + 512 * pi; }
    else if (pi < 11) { st = 4; kb = tq0 - 256 + 128 * (pi - 5); }
    else { st = 1; kb = tq0 - 64 + 32 * (pi - 11); }
}
__device__ __forceinline__ void att_load(const bf16* QKVb, int h, int st, int kb, int lane, bf16x8 (&kf)[2][2], u32x4 (&vv)[4]) {
    const int fr = lane & 15, fq = lane >> 4;
#pragma unroll
    for (int ab = 0; ab < 2; ++ab) { int tk = kb + st * (16 * ab + fr); tk = tk < 0 ? 0 : (tk > SEQ - 1 ? SEQ - 1 : tk);
        const bf16* kp = QKVb + (size_t)tk * NQKV + 512 + h * 64 + 8 * fq;
        kf[ab][0] = *(const bf16x8*)kp; kf[ab][1] = *(const bf16x8*)(kp + 32); }
#pragma unroll
    for (int e = 0; e < 4; ++e) { int tk = kb + st * (8 * e + (lane >> 3)); tk = tk < 0 ? 0 : (tk > SEQ - 1 ? SEQ - 1 : tk);
        vv[e] = *(const u32x4*)(QKVb + (size_t)tk * NQKV + 1024 + h * 64 + (lane & 7) * 8); }
}
__device__ __forceinline__ void attn_item(const Params& p, LAS unsigned char* vl, int item, int lane) {
    const int rcls = item & 15, stile = (item >> 4) & 7, h = (item >> 7) & 7, b = item >> 10;
    const int fr = lane & 15, fq = lane >> 4;
    const bf16* QKVb = (const bf16*)(p.ws + WS_QKV) + (size_t)b * SEQ * NQKV;
    const int tq0 = 256 * stile + rcls, tq = tq0 + 16 * fr;
    bf16x8 qf[2];
    { const bf16* qp = QKVb + (size_t)tq * NQKV + h * 64 + 8 * fq; qf[0] = *(const bf16x8*)qp; qf[1] = *(const bf16x8*)(qp + 32); }
    const float LOG2E = 1.4426950408889634f, NEG = -1e30f;
    const float slope2 = __builtin_amdgcn_exp2f(-(float)(h + 1)) * LOG2E, sc2 = 0.125f * LOG2E;
    float m = NEG, lpart = 0.f; f32x4 oacc[4];
#pragma unroll
    for (int mt = 0; mt < 4; ++mt) oacc[mt] = (f32x4){0.f, 0.f, 0.f, 0.f};
    bf16x8 kf[2][2], kfn[2][2]; u32x4 vv[4], vvn[4];
    int st, kb; att_pair_params(0, tq0, st, kb); att_load(QKVb, h, st, kb, lane, kf, vv);
    for (int pi = 0; pi < ATT_NPAIR; ++pi) {
        int stn = st, kbn = kb;
        if (pi + 1 < ATT_NPAIR) { att_pair_params(pi + 1, tq0, stn, kbn); att_load(QKVb, h, stn, kbn, lane, kfn, vvn); }
        f32x4 s[2];
#pragma unroll
        for (int ab = 0; ab < 2; ++ab) { s[ab] = (f32x4){0.f, 0.f, 0.f, 0.f};
            s[ab] = __builtin_amdgcn_mfma_f32_16x16x32_bf16(kf[ab][0], qf[0], s[ab], 0, 0, 0);
            s[ab] = __builtin_amdgcn_mfma_f32_16x16x32_bf16(kf[ab][1], qf[1], s[ab], 0, 0, 0); }
        float sv[8]; float mx = NEG;
#pragma unroll
        for (int ab = 0; ab < 2; ++ab)
#pragma unroll
            for (int r = 0; r < 4; ++r) { const int tk = kb + st * (16 * ab + 4 * fq + r); const int dl = tk - tq, adl = dl < 0 ? -dl : dl;
                const bool valid = ((unsigned)tk < (unsigned)SEQ) && (adl <= 64 * st);
                const float x = s[ab][r] * sc2 - slope2 * (float)adl; sv[ab * 4 + r] = valid ? x : NEG; mx = fmaxf(mx, sv[ab * 4 + r]); }
        mx = fmaxf(mx, __shfl_xor(mx, 16)); mx = fmaxf(mx, __shfl_xor(mx, 32));
        const float mnew = fmaxf(m, mx), alpha = __builtin_amdgcn_exp2f(m - mnew); m = mnew;
        float pv[8], ps = 0.f;
#pragma unroll
        for (int i = 0; i < 8; ++i) { pv[i] = sv[i] > -1e29f ? __builtin_amdgcn_exp2f(sv[i] - mnew) : 0.f; ps += pv[i]; }
        lpart = lpart * alpha + ps;
#pragma unroll
        for (int mt = 0; mt < 4; ++mt) oacc[mt] = oacc[mt] * alpha;
        u32x4 pw; pw.x = cvt_pk_bf16(pv[0], pv[1]); pw.y = cvt_pk_bf16(pv[2], pv[3]); pw.z = cvt_pk_bf16(pv[4], pv[5]); pw.w = cvt_pk_bf16(pv[6], pv[7]);
        const bf16x8 pb = __builtin_bit_cast(bf16x8, pw);
        asm volatile("" ::: "memory");
#pragma unroll
        for (int e = 0; e < 4; ++e) *(LAS u32x4*)(vl + (8 * e + (lane >> 3)) * ATT_VROW + (lane & 7) * 16) = vv[e];
        LDS_WAIT();
        const LAS unsigned char* va = vl + (4 * fq + (fr >> 2)) * ATT_VROW + (fr & 3) * 8;
#pragma unroll
        for (int mt = 0; mt < 4; ++mt) { const s16x4 lo = vtr(va + mt * 32), hi = vtr(va + 16 * ATT_VROW + mt * 32);
            const bf16x8 vf = (bf16x8){lo[0], lo[1], lo[2], lo[3], hi[0], hi[1], hi[2], hi[3]};
            oacc[mt] = __builtin_amdgcn_mfma_f32_16x16x32_bf16(vf, pb, oacc[mt], 0, 0, 0); }
        LDS_WAIT();
        st = stn; kb = kbn;
#pragma unroll
        for (int ab = 0; ab < 2; ++ab) { kf[ab][0] = kfn[ab][0]; kf[ab][1] = kfn[ab][1]; }
#pragma unroll
        for (int e = 0; e < 4; ++e) vv[e] = vvn[e];
    }
    float l = lpart; l += __shfl_xor(l, 16); l += __shfl_xor(l, 32);
    const float inv = 1.0f / l;
    bf16* yp = (bf16*)(p.ws + WS_YA) + (size_t)(b * SEQ + tq) * DH + h * 64 + 4 * fq;
#pragma unroll
    for (int mt = 0; mt < 4; ++mt) { u32x2 w; w.x = cvt_pk_bf16(oacc[mt][0] * inv, oacc[mt][1] * inv); w.y = cvt_pk_bf16(oacc[mt][2] * inv, oacc[mt][3] * inv); *(u32x2*)(yp + 16 * mt) = w; }
}

__device__ __forceinline__ void mixnorm_unit(const Params& p, LAS unsigned char* lds, int unit, int tid) {
    constexpr int RS = 136;
    const int m0 = unit * 64, lane = tid & 63, wave = tid >> 6;
    const bf16* YHT = (const bf16*)(p.ws + WS_YHT); const bf16* YA = (const bf16*)(p.ws + WS_YA); bf16* Y = (bf16*)(p.ws + WS_Y);
    __syncthreads();
    { const u32x4* src = (const u32x4*)(YHT + (size_t)tid * M + m0);
#pragma unroll
        for (int q = 0; q < 8; ++q) { const u32x4 v = src[q]; LAS unsigned* d = (LAS unsigned*)(lds + tid * RS + q * 16); d[0] = v.x; d[1] = v.y; d[2] = v.z; d[3] = v.w; } }
    __syncthreads();
    const float* ghy = p.in[I_GHY]; const float* gat = p.in[I_GAT];
    for (int k = 0; k < 8; ++k) {
        const int tok = 8 * wave + k, mrow = m0 + tok;
        float v[8]; float s = 0.f;
#pragma unroll
        for (int q = 0; q < 4; ++q) { const int c = 2 * lane + 128 * q;
            v[2 * q] = bf2f(*(const LAS bf16*)(lds + c * RS + tok * 2)); v[2 * q + 1] = bf2f(*(const LAS bf16*)(lds + (c + 1) * RS + tok * 2));
            s += v[2 * q] * v[2 * q] + v[2 * q + 1] * v[2 * q + 1]; }
        const float rstd = 1.0f / sqrtf(wave_sum(s) * (1.f / DH) + RMS_EPS);
#pragma unroll
        for (int q = 0; q < 4; ++q) { const int c = 2 * lane + 128 * q;
            *(unsigned*)(Y + (size_t)mrow * D + c) = cvt_pk_bf16(v[2 * q] * rstd * ghy[c], v[2 * q + 1] * rstd * ghy[c + 1]); }
        const u32x4 a = *(const u32x4*)(YA + (size_t)mrow * DH + 8 * lane);
        float w[8]; w[0] = bf2f(a.x & 0xffffu); w[1] = bf2f(a.x >> 16); w[2] = bf2f(a.y & 0xffffu); w[3] = bf2f(a.y >> 16); w[4] = bf2f(a.z & 0xffffu); w[5] = bf2f(a.z >> 16); w[6] = bf2f(a.w & 0xffffu); w[7] = bf2f(a.w >> 16);
        float s2 = 0.f;
#pragma unroll
        for (int e = 0; e < 8; ++e) s2 += w[e] * w[e];
        const float rstd2 = 1.0f / sqrtf(wave_sum(s2) * (1.f / DH) + RMS_EPS);
        const f32x4 g0 = *(const f32x4*)(gat + 8 * lane), g1 = *(const f32x4*)(gat + 8 * lane + 4);
        u32x4 o; o.x = cvt_pk_bf16(w[0] * rstd2 * g0.x, w[1] * rstd2 * g0.y); o.y = cvt_pk_bf16(w[2] * rstd2 * g0.z, w[3] * rstd2 * g0.w);
        o.z = cvt_pk_bf16(w[4] * rstd2 * g1.x, w[5] * rstd2 * g1.y); o.w = cvt_pk_bf16(w[6] * rstd2 * g1.z, w[7] * rstd2 * g1.w);
        *(u32x4*)(Y + (size_t)mrow * D + DH + 8 * lane) = o;
    }
}

__global__ void __launch_bounds__(NWAVES * 64, 2) fwd_kernel(Params p) {
    extern __shared__ __attribute__((aligned(16))) unsigned char lds_raw[];
    LAS unsigned char* lds = (LAS unsigned char*)lds_raw;
    cg::grid_group grid = cg::this_grid();
    const int tid = threadIdx.x, lane = tid & 63, wave = __builtin_amdgcn_readfirstlane(tid >> 6);
    const int G = gridDim.x, bx = blockIdx.x;
    const int gw = bx * NWAVES + wave, NGW = G * NWAVES;
    unsigned char* ws = p.ws;
    bf16* W1A = (bf16*)(ws + WS_W1A); bf16* W1D = (bf16*)(ws + WS_W1D); bf16* WIN = (bf16*)(ws + WS_WIN); bf16* WOUT = (bf16*)(ws + WS_WOUT);
    bf16* W2A = (bf16*)(ws + WS_W2A); bf16* W2D = (bf16*)(ws + WS_W2D); bf16* XN = (bf16*)(ws + WS_XN); bf16* HB = (bf16*)(ws + WS_H);
    bf16* PT = (bf16*)(ws + WS_PT); bf16* QKV = (bf16*)(ws + WS_QKV); bf16* Y = (bf16*)(ws + WS_Y);

    {
        LAS float* scr = (LAS float*)(lds + wave * 16384);
        constexpr int I_UP = 16 * 88, I_DN = 44 * 32, I_IN = 16 * 96, I_OUT = 16 * 32;
        constexpr int NITEMS = 2 * (2 * I_UP + I_DN) + I_IN + I_OUT;
        for (int it = gw; it < NITEMS; it += NGW) {
            int r = it;
            if (r < I_UP) { p0_transpose_mat(p.in[I_WG1], D, FF, W1A, 1, r, scr, lane); continue; } r -= I_UP;
            if (r < I_UP) { p0_transpose_mat(p.in[I_WU1], D, FF, W1A, 2, r, scr, lane); continue; } r -= I_UP;
            if (r < I_DN) { p0_transpose_mat(p.in[I_WD1], FF, D, W1D, 0, r, scr, lane); continue; } r -= I_DN;
            if (r < I_UP) { p0_transpose_mat(p.in[I_WG2], D, FF, W2A, 1, r, scr, lane); continue; } r -= I_UP;
            if (r < I_UP) { p0_transpose_mat(p.in[I_WU2], D, FF, W2A, 2, r, scr, lane); continue; } r -= I_UP;
            if (r < I_DN) { p0_transpose_mat(p.in[I_WD2], FF, D, W2D, 0, r, scr, lane); continue; } r -= I_DN;
            if (r < I_IN) { p0_transpose_mat(p.in[I_WIN], D, 3072, WIN, 0, r, scr, lane); continue; } r -= I_IN;
            p0_transpose_mat(p.in[I_WOUT], D, D, WOUT, 0, r, scr, lane);
        }
        for (int m = gw; m < M; m += NGW) rms_row_to_bf16(p.in[I_X] + (size_t)m * D, p.in[I_G1], XN + (size_t)m * D, lane);
        __syncthreads();
        filt_stage1(p, lds, tid);
    }
    grid.sync();
    filt_stage2(p, lds, tid);
    {
        pg8::Gemm g{XN, W1A, M, 2 * FF, D, nullptr, nullptr}; pg8::StaticOrder S; S.init(M, 2 * FF, G, bx);
        pg8::EpiSwiglu E{HB, FF};
        pg8::gemm_phase<pg8::EpiSwiglu, pg8::StaticOrder, true, true>(lds, g, S, E);
    }
    grid.sync();
    {
        pg8::Gemm g{HB, W1D, M, D, FF, nullptr, nullptr}; pg8::StaticOrder S; S.init(M, D, G, bx);
        pg8::EpiResid E{p.in[I_X], p.out, D, 0.5f};
        pg8::gemm_phase<pg8::EpiResid, pg8::StaticOrder, true, true>(lds, g, S, E);
    }
    grid.sync();
    for (int m = gw; m < M; m += NGW) rms_row_to_bf16(p.out + (size_t)m * D, p.in[I_GMIX], XN + (size_t)m * D, lane);
    grid.sync();
    {
        pg8::Gemm g{WIN, XN, 0, 0, D, XN, WIN + (size_t)NQKV * D}; pg8::WinOrder S; S.init(G, bx);
        pg8::EpiStore2 E{PT, M, QKV, NQKV};
        pg8::gemm_phase<pg8::EpiStore2, pg8::WinOrder, true, true>(lds, g, S, E);
    }
    grid.sync();
    for (int c = bx; c < DH; c += G) conv_unit_mfma(p, lds, c, tid);
    __syncthreads();
    for (int it = gw; it < 8192; it += NGW) attn_item(p, lds + wave * ATT_WAVE_LDS, it, lane);
    grid.sync();
    for (int u = bx; u < M / 64; u += G) mixnorm_unit(p, lds, u, tid);
    __syncthreads();
    grid.sync();
    {
        pg8::Gemm g{Y, WOUT, M, D, D, nullptr, nullptr}; pg8::StaticOrder S; S.init(M, D, G, bx);
        pg8::EpiResid E{p.out, p.out, D, 1.0f};
        pg8::gemm_phase<pg8::EpiResid, pg8::StaticOrder, true, true>(lds, g, S, E);
    }
    grid.sync();
    for (int m = gw; m < M; m += NGW) rms_row_to_bf16(p.out + (size_t)m * D, p.in[I_G2], XN + (size_t)m * D, lane);
    grid.sync();
    {
        pg8::Gemm g{XN, W2A, M, 2 * FF, D, nullptr, nullptr}; pg8::StaticOrder S; S.init(M, 2 * FF, G, bx);
        pg8::EpiSwiglu E{HB, FF};
        pg8::gemm_phase<pg8::EpiSwiglu, pg8::StaticOrder, true, true>(lds, g, S, E);
    }
    grid.sync();
    {
        pg8::Gemm g{HB, W2D, M, D, FF, nullptr, nullptr}; pg8::StaticOrder S; S.init(M, D, G, bx);
        pg8::EpiResid E{p.out, p.out, D, 0.5f};
        pg8::gemm_phase<pg8::EpiResid, pg8::StaticOrder, true, true>(lds, g, S, E);
    }
    grid.sync();
    for (int m = gw; m < M; m += NGW) rms_row_to_f32(p.out + (size_t)m * D, p.in[I_GFIN], p.out + (size_t)m * D, lane);
}

extern "C" void kernel_launch(void* const* d_in, const int* in_sizes, int n_in, void* d_out, int out_size, void* d_ws, size_t ws_size, hipStream_t stream) {
    static int grid = 0;
    if (grid == 0) {
        if (n_in != 26 || in_sizes[0] != M * D || out_size != M * D || ws_size < WS_END) { fprintf(stderr, "kernel_launch: unexpected shapes (n_in %d, in0 %d, out %d, ws %zu)\n", n_in, n_in > 0 ? in_sizes[0] : -1, out_size, ws_size); grid = -1; return; }
        int dev = 0, cus = 0, per_cu = 0;
        hipGetDevice(&dev); hipDeviceGetAttribute(&cus, hipDeviceAttributeMultiprocessorCount, dev);
        if (hipFuncSetAttribute((const void*)fwd_kernel, hipFuncAttributeMaxDynamicSharedMemorySize, LDS_BYTES) != hipSuccess) { fprintf(stderr, "kernel_launch: hipFuncSetAttribute failed\n"); grid = -1; return; }
        if (hipOccupancyMaxActiveBlocksPerMultiprocessor(&per_cu, (const void*)fwd_kernel, NWAVES * 64, LDS_BYTES) != hipSuccess || per_cu < 1) { fprintf(stderr, "kernel_launch: occupancy query says %d blocks per CU\n", per_cu); (void)hipGetLastError(); grid = -1; return; }
        grid = cus;
    }
    if (grid < 0) return;
    Params prm{};
    for (int i = 0; i < 26; ++i) prm.in[i] = (const float*)d_in[i];
    prm.out = (float*)d_out; prm.ws = (unsigned char*)d_ws;
    void* args[] = {&prm};
    hipError_t e = hipLaunchCooperativeKernel((const void*)fwd_kernel, dim3(grid), dim3(NWAVES * 64), args, LDS_BYTES, stream);
    if (e != hipSuccess) fprintf(stderr, "kernel_launch: cooperative launch failed: %s (grid %d)\n", hipGetErrorString(e), grid);
}
```

```cpp
#include <hip/hip_runtime.h>
#include <hip/hip_cooperative_groups.h>
#include <cstdio>
#include <cstdint>
namespace cg = cooperative_groups;
namespace pg8 {
#define PG8_LAS __attribute__((address_space(3)))
typedef unsigned short bf16_t;
typedef short bf16x8 __attribute__((ext_vector_type(8)));
typedef float f32x4 __attribute__((ext_vector_type(4)));
typedef unsigned u32x4 __attribute__((ext_vector_type(4)));
constexpr int BM = 256, BK = 64, HALF = 128, HTB = HALF * BK * 2  , STAGE_BYTES = 8 * HTB, NXCD = 8, WGM = 8;

__host__ __device__ __forceinline__ int lds_byte(int r, int c) { const int st = (r >> 4) * 2 + (c >> 5), rr = r & 15, cc = c & 31, ob = rr * 64 + cc * 2; return st * 1024 + (ob ^ (((ob >> 9) & 1) << 5)); }
__host__ __device__ __forceinline__ void stage_rc(int b, int& R, int& C) { const int st = b / 1024, sb = b % 1024, swz = sb ^ (((sb >> 9) & 1) << 5); R = (st >> 1) * 16 + swz / 64; C = (st & 1) * 32 + (swz % 64) / 2; }
__host__ __device__ __forceinline__ int perm32(int rho) { const int n = rho >> 4, i = rho & 15; return 8 * (i >> 2) + 4 * n + (i & 3); }

struct Unit { int pm, pn, z; };
struct Gemm { const bf16_t* A; const bf16_t* Bt; int M, N, K; const bf16_t* A2; const bf16_t* Bt2; };

struct StaticOrder {
    int nM, nN, nwg, G, c;
    __host__ __device__ void init(int M, int N, int G_, int c_) { nM = M / BM; nN = N / BM; nwg = nM * nN; G = G_; c = c_; }
    __host__ __device__ bool next(int i, Unit& u) const {
        const long L = (long)i * G + c; if (L >= nwg) return false;
        int wgid = (int)L; { const int q = nwg / NXCD, r = nwg % NXCD, xcd = wgid % NXCD, off = wgid / NXCD; wgid = (xcd < r ? xcd * (q + 1) : r * (q + 1) + (xcd - r) * q) + off; }
        const int nig = WGM * nN, gid = wgid / nig, fm = gid * WGM, gsz = (nM - fm) < WGM ? (nM - fm) : WGM;
        u.pm = fm + ((wgid % nig) % gsz); u.pn = (wgid % nig) / gsz; u.z = 0; return true;
    }
    __device__ __forceinline__ void a_ready(const Unit&) const {}
    __device__ __forceinline__ void done(const Unit&) const {}
};

__device__ __forceinline__ unsigned cvt_pk_bf16(float lo, float hi) { unsigned r; asm volatile("v_cvt_pk_bf16_f32 %0, %1, %2" : "=v"(r) : "v"(lo), "v"(hi)); return r; }
typedef float f32x2 __attribute__((ext_vector_type(2)));
__device__ __forceinline__ f32x2 gelu_pk(f32x2 v) {
    const f32x2 av = __builtin_elementwise_abs(v), d = av * 0.2316418882f + 1.0f;
    f32x2 t; t.x = __builtin_amdgcn_rcpf(d.x); t.y = __builtin_amdgcn_rcpf(d.y);
    f32x2 q = t * 0.5307027145f + (-0.7265760135f); q = q * t + 0.7107068705f; q = q * t + (-0.142248368f); q = q * t + 0.127414796f; q = q * t;
    const f32x2 s = (v * v) * (-0.72134752044f);
    f32x2 e; e.x = __builtin_amdgcn_exp2f(s.x); e.y = __builtin_amdgcn_exp2f(s.y);
    const f32x2 m = v * (q * e), r = v - m;
    f32x2 o; o.x = v.x < 0.f ? m.x : r.x; o.y = v.y < 0.f ? m.y : r.y; return o;
}

struct EpiSwiglu {
    static constexpr bool PERM = true, AFTER_DRAIN = false;
    bf16_t* H; int ldh;
    __device__ __forceinline__ void operator()(const f32x4 (&acc)[2][2][4][2], const Unit& u, int wr, int wc, int fr, int fq) const {
        const int row0 = u.pm * BM + wr * 64 + fr, col0 = u.pn * HALF + wc * 32 + 8 * fq;
#pragma unroll
        for (int ai = 0; ai < 2; ++ai)
#pragma unroll
            for (int m = 0; m < 4; ++m) { bf16_t* rowp = H + (size_t)(row0 + ai * HALF + m * 16) * ldh + col0;
                float o[8];
#pragma unroll
                for (int n = 0; n < 2; ++n)
#pragma unroll
                    for (int e = 0; e < 4; ++e) { const float g = acc[ai][0][m][n][e], up = acc[ai][1][m][n][e];
                        const float sg = g * __builtin_amdgcn_rcpf(1.0f + __builtin_amdgcn_exp2f(-1.4426950408889634f * g)); o[n * 4 + e] = sg * up; }
                u32x4 w; w.x = cvt_pk_bf16(o[0], o[1]); w.y = cvt_pk_bf16(o[2], o[3]); w.z = cvt_pk_bf16(o[4], o[5]); w.w = cvt_pk_bf16(o[6], o[7]);
                *(u32x4*)rowp = w; }
    }
};
struct EpiResid {
    static constexpr bool PERM = false, AFTER_DRAIN = false;
    const float* base; float* out; int ldc; float scale;
    __device__ __forceinline__ void operator()(const f32x4 (&acc)[2][2][4][2], const Unit& u, int wr, int wc, int fr, int fq) const {
        const int row0 = u.pm * BM + wr * 64 + fr, col0 = u.pn * BM + wc * 32 + 4 * fq;
#pragma unroll
        for (int ai = 0; ai < 2; ++ai)
#pragma unroll
            for (int m = 0; m < 4; ++m) { const size_t off = (size_t)(row0 + ai * HALF + m * 16) * ldc + col0;
#pragma unroll
                for (int bj = 0; bj < 2; ++bj)
#pragma unroll
                    for (int n = 0; n < 2; ++n) { const f32x4 bs = *(const f32x4*)(base + off + bj * HALF + n * 16);
                        *(f32x4*)(out + off + bj * HALF + n * 16) = bs + acc[ai][bj][m][n] * scale; } }
    }
};
struct EpiStore2 {
    static constexpr bool PERM = true, AFTER_DRAIN = false;
    bf16_t* O0; int ld0; bf16_t* O1; int ld1;
    __device__ __forceinline__ void operator()(const f32x4 (&acc)[2][2][4][2], const Unit& u, int wr, int wc, int fr, int fq) const {
        bf16_t* O = u.z ? O1 : O0; const int ldc = u.z ? ld1 : ld0;
        const int row0 = u.pm * BM + wr * 64 + fr, col0 = u.pn * BM + wc * 32 + 8 * fq;
#pragma unroll
        for (int ai = 0; ai < 2; ++ai)
#pragma unroll
            for (int m = 0; m < 4; ++m) { bf16_t* rowp = O + (size_t)(row0 + ai * HALF + m * 16) * ldc + col0;
#pragma unroll
                for (int bj = 0; bj < 2; ++bj) { const f32x4 v0 = acc[ai][bj][m][0], v1 = acc[ai][bj][m][1];
                    u32x4 w; w.x = cvt_pk_bf16(v0[0], v0[1]); w.y = cvt_pk_bf16(v0[2], v0[3]); w.z = cvt_pk_bf16(v1[0], v1[1]); w.w = cvt_pk_bf16(v1[2], v1[3]);
                    *(u32x4*)(rowp + bj * HALF) = w; } }
    }
};
struct WinOrder {
    StaticOrder so;
    __host__ __device__ void init(int G_, int c_) { so.init(64 * BM, 12 * BM, G_, c_); }
    __host__ __device__ bool next(int i, Unit& u) const {
        Unit v; if (!so.next(i, v)) return false;
        if (v.pn < 6) { u.pm = v.pn; u.pn = v.pm; u.z = 0; } else { u.pm = v.pm; u.pn = v.pn - 6; u.z = 1; }
        return true;
    }
    __device__ __forceinline__ void a_ready(const Unit&) const {}
    __device__ __forceinline__ void done(const Unit&) const {}
};
template <class Epi, class Sched, bool ALIGN_EPI = false, bool SP2 = false>
__device__ __forceinline__ void gemm_phase(PG8_LAS unsigned char* lds, const Gemm g, const Sched& S, const Epi& E) {
    int tid_ = threadIdx.x; asm volatile("" : "+v"(tid_));
    const int tid = tid_, wid = __builtin_amdgcn_readfirstlane(tid >> 6), lane = tid & 63, wr = wid >> 2, wc = wid & 3, fr = lane & 15, fq = lane >> 4;
    const int K = g.K, nt = K / BK;
    unsigned voffA[2], voffB[2];
#pragma unroll
    for (int i = 0; i < 2; ++i) { int R, C; stage_rc(tid * 16 + i * 8192, R, C); const int Rb = Epi::PERM ? ((R & ~31) + perm32(R & 31)) : R;
        voffA[i] = (unsigned)(R * K + C) * 2u; voffB[i] = (unsigned)(Rb * K + C) * 2u; }
    const size_t kstep = (size_t)(BK * 2);
    const size_t hstep = (size_t)HALF * K * 2;
    const size_t tstep = 2 * hstep;
    const unsigned ldsw = (unsigned)wid * 1024u;
    const int aoff = lds_byte(wr * 64 + fr, fq * 8), boff = lds_byte(wc * 32 + fr, fq * 8);
#define PG8_SA(b, h) (((b) * 2 + (h)) * HTB)
#define PG8_SB(b, h) ((4 + (b) * 2 + (h)) * HTB)
#define PG8_STAGE(bufoff, gbase, voff) do { _Pragma("unroll") for (int _i = 0; _i < 2; ++_i) \
        __builtin_amdgcn_global_load_lds((const unsigned*)((const char*)(gbase) + (voff)[_i]), (PG8_LAS unsigned*)(lds + (bufoff) + ldsw + _i * 8192), 16, 0, 0); } while (0)
#define PG8_LDA(dst, b, h) do { _Pragma("unroll") for (int m = 0; m < 4; ++m) _Pragma("unroll") for (int k = 0; k < 2; ++k) dst[m][k] = *(const PG8_LAS bf16x8*)(lds + PG8_SA(b, h) + aoff + m * 2048 + k * 1024); } while (0)
#define PG8_LDB(dst, b, h) do { _Pragma("unroll") for (int n = 0; n < 2; ++n) _Pragma("unroll") for (int k = 0; k < 2; ++k) dst[n][k] = *(const PG8_LAS bf16x8*)(lds + PG8_SB(b, h) + boff + n * 2048 + k * 1024); } while (0)
#define PG8_MMA(ai, bj, At, Bt) do { __builtin_amdgcn_s_setprio(1); _Pragma("unroll") for (int m = 0; m < 4; ++m) _Pragma("unroll") for (int n = 0; n < 2; ++n) _Pragma("unroll") for (int k = 0; k < 2; ++k) \
        acc[ai][bj][m][n] = __builtin_amdgcn_mfma_f32_16x16x32_bf16(Bt[n][k], At[m][k], acc[ai][bj][m][n], 0, 0, 0); __builtin_amdgcn_s_setprio(0); } while (0)
#define PG8_WAIT_V(n) asm volatile("s_waitcnt vmcnt(" #n ")" ::: "memory")
#define PG8_WAIT_L(n) asm volatile("s_waitcnt lgkmcnt(" #n ")" ::: "memory")
#define PG8_BAR __builtin_amdgcn_s_barrier()
#define PG8_SCHED __builtin_amdgcn_sched_barrier(0)
    Unit cur, nxt; int ui = 0;
    if (!S.next(0, cur)) return;
    f32x4 acc[2][2][4][2];
#pragma unroll
    for (int a = 0; a < 2; ++a)
#pragma unroll
        for (int b = 0; b < 2; ++b)
#pragma unroll
            for (int m = 0; m < 4; ++m)
#pragma unroll
                for (int n = 0; n < 2; ++n) acc[a][b][m][n] = (f32x4){0.f, 0.f, 0.f, 0.f};
    bf16x8 At[4][2], B0[2][2], B1[2][2];
    const char* cA = (const char*)(cur.z ? g.A2 : g.A) + (size_t)cur.pm * tstep; const char* cB = (const char*)(cur.z ? g.Bt2 : g.Bt) + (size_t)cur.pn * tstep;
    S.a_ready(cur);
    if constexpr (SP2) {
        PG8_STAGE(PG8_SB(0, 0), cB, voffB); PG8_STAGE(PG8_SB(0, 1), cB + hstep, voffB); PG8_STAGE(PG8_SA(0, 0), cA, voffA); PG8_STAGE(PG8_SA(0, 1), cA + hstep, voffA);
        if (wr == 1) PG8_BAR;
        PG8_WAIT_V(2); PG8_BAR;
        PG8_STAGE(PG8_SB(1, 0), cB + kstep, voffB); PG8_STAGE(PG8_SA(1, 0), cA + kstep, voffA); PG8_STAGE(PG8_SB(1, 1), cB + hstep + kstep, voffB);
        PG8_WAIT_V(6); PG8_BAR;
    } else {
        PG8_STAGE(PG8_SB(0, 0), cB, voffB); PG8_STAGE(PG8_SA(0, 0), cA, voffA); PG8_STAGE(PG8_SB(0, 1), cB + hstep, voffB); PG8_STAGE(PG8_SA(0, 1), cA + hstep, voffA);
        if (wr == 1) PG8_BAR;
        PG8_WAIT_V(4); PG8_BAR;
        PG8_STAGE(PG8_SB(1, 0), cB + kstep, voffB); PG8_STAGE(PG8_SA(1, 0), cA + kstep, voffA); PG8_STAGE(PG8_SB(1, 1), cB + hstep + kstep, voffB);
        PG8_WAIT_V(6); PG8_BAR;
    }
    for (;;) {
        const bool has_next = S.next(ui + 1, nxt);
        const char* nA = has_next ? (const char*)(nxt.z ? g.A2 : g.A) + (size_t)nxt.pm * tstep : cA; const char* nB = has_next ? (const char*)(nxt.z ? g.Bt2 : g.Bt) + (size_t)nxt.pn * tstep : cB;
        for (int t = 0; t < nt; t += 2) {
            const bool last = (t == nt - 2);
            const char* a1 = cA + (size_t)(t + 1) * kstep;
            const char* a2 = last ? nA : cA + (size_t)(t + 2) * kstep; const char* b2 = last ? nB : cB + (size_t)(t + 2) * kstep;
            const char* a3 = a2 + kstep; const char* b3 = b2 + kstep;
            if (last && has_next) S.a_ready(nxt);
            if constexpr (SP2) {
            PG8_LDB(B0, 0, 0); PG8_LDB(B1, 0, 1); PG8_SCHED; PG8_LDA(At, 0, 0); PG8_STAGE(PG8_SA(1, 1), a1 + hstep, voffA);
            PG8_WAIT_V(8); PG8_WAIT_L(0); PG8_BAR; PG8_MMA(0, 0, At, B0); PG8_MMA(0, 1, At, B1); PG8_BAR; PG8_SCHED;
            PG8_LDA(At, 0, 1); PG8_STAGE(PG8_SB(0, 0), b2, voffB); PG8_STAGE(PG8_SB(0, 1), b2 + hstep, voffB); PG8_STAGE(PG8_SA(0, 0), a2, voffA);
            PG8_WAIT_V(8); PG8_WAIT_L(0); PG8_BAR; PG8_MMA(1, 0, At, B0); PG8_MMA(1, 1, At, B1); PG8_BAR; PG8_SCHED;
            PG8_LDB(B0, 1, 0); PG8_LDB(B1, 1, 1); PG8_SCHED; PG8_LDA(At, 1, 0); PG8_STAGE(PG8_SA(0, 1), a2 + hstep, voffA);
            PG8_WAIT_V(8); PG8_WAIT_L(0); PG8_BAR; PG8_MMA(0, 0, At, B0); PG8_MMA(0, 1, At, B1); PG8_BAR; PG8_SCHED;
            PG8_LDA(At, 1, 1); PG8_STAGE(PG8_SB(1, 0), b3, voffB); PG8_STAGE(PG8_SB(1, 1), b3 + hstep, voffB); PG8_STAGE(PG8_SA(1, 0), a3, voffA);
            PG8_WAIT_V(8); PG8_WAIT_L(0); PG8_BAR; PG8_MMA(1, 0, At, B0); PG8_MMA(1, 1, At, B1); PG8_BAR; PG8_SCHED;
            } else {
            PG8_LDB(B0, 0, 0); PG8_SCHED; PG8_LDA(At, 0, 0); PG8_STAGE(PG8_SA(1, 1), a1 + hstep, voffA);
            PG8_WAIT_L(8); PG8_BAR; PG8_WAIT_L(0); PG8_MMA(0, 0, At, B0); PG8_BAR; PG8_SCHED;
            PG8_LDB(B1, 0, 1); PG8_STAGE(PG8_SB(0, 0), b2, voffB);
            PG8_BAR; PG8_WAIT_L(0); PG8_MMA(0, 1, At, B1); PG8_BAR;
            PG8_LDA(At, 0, 1); PG8_STAGE(PG8_SA(0, 0), a2, voffA);
            PG8_BAR; PG8_WAIT_L(0); PG8_MMA(1, 0, At, B0); PG8_BAR; PG8_SCHED;
            PG8_STAGE(PG8_SB(0, 1), b2 + hstep, voffB);
            PG8_WAIT_V(6); PG8_BAR; PG8_MMA(1, 1, At, B1); PG8_BAR;
            PG8_LDB(B0, 1, 0); PG8_SCHED; PG8_LDA(At, 1, 0); PG8_STAGE(PG8_SA(0, 1), a2 + hstep, voffA);
            PG8_WAIT_L(8); PG8_BAR; PG8_WAIT_L(0); PG8_MMA(0, 0, At, B0); PG8_BAR; PG8_SCHED;
            PG8_LDB(B1, 1, 1); PG8_STAGE(PG8_SB(1, 0), b3, voffB);
            PG8_BAR; PG8_WAIT_L(0); PG8_MMA(0, 1, At, B1); PG8_BAR;
            PG8_LDA(At, 1, 1); PG8_STAGE(PG8_SA(1, 0), a3, voffA);
            PG8_BAR; PG8_WAIT_L(0); PG8_MMA(1, 0, At, B0); PG8_BAR; PG8_SCHED;
            PG8_STAGE(PG8_SB(1, 1), b3 + hstep, voffB);
            PG8_WAIT_V(6); PG8_BAR; PG8_MMA(1, 1, At, B1); PG8_BAR;
            }
        }
        if constexpr (ALIGN_EPI) { if (wr == 0) PG8_BAR; }
        if constexpr (!Epi::AFTER_DRAIN) { E(acc, cur, wr, wc, fr, fq); S.done(cur); }
        if (!has_next) break;
#pragma unroll
        for (int a = 0; a < 2; ++a)
#pragma unroll
            for (int b = 0; b < 2; ++b)
#pragma unroll
                for (int m = 0; m < 4; ++m)
#pragma unroll
                    for (int n = 0; n < 2; ++n) acc[a][b][m][n] = (f32x4){0.f, 0.f, 0.f, 0.f};
        cur = nxt; cA = nA; cB = nB; ++ui;
        if constexpr (ALIGN_EPI) { if (wr == 1) PG8_BAR; }
    }
    PG8_WAIT_V(0);
    if constexpr (!ALIGN_EPI) { if (wr == 0) PG8_BAR; }
    PG8_BAR;
    if constexpr (Epi::AFTER_DRAIN) { E.fused(acc, cur, wr, wc, fr, fq, lds, wid, lane); S.done(cur); }
#undef PG8_SA
#undef PG8_SB
#undef PG8_STAGE
#undef PG8_LDA
#undef PG8_LDB
#undef PG8_MMA
#undef PG8_WAIT_V
#undef PG8_WAIT_L
#undef PG8_BAR
#undef PG8_SCHED
}
}
constexpr int NWAVES = 8;
constexpr int M = 16384, D = 1024, FF = 2816, NBATCH = 8, SEQ = 2048, DH = 512, NQKV = 1536;
constexpr float RMS_EPS = 1e-6f;
constexpr int LDS_BYTES = 147456;
constexpr size_t MiB = 1u << 20;
constexpr size_t WS_W1A = 0, WS_W1D = 11 * MiB, WS_WIN = 17 * MiB, WS_WOUT = 23 * MiB, WS_W2A = 25 * MiB, WS_W2D = 36 * MiB;
constexpr size_t WS_XN = 42 * MiB;
constexpr size_t WS_H = 74 * MiB;
constexpr size_t WS_PT = 74 * MiB;
constexpr size_t WS_QKV = 122 * MiB;
constexpr size_t WS_YHT = 170 * MiB;
constexpr size_t WS_YA = 186 * MiB;
constexpr size_t WS_Y = 202 * MiB;
constexpr size_t WS_G = 234 * MiB;
constexpr size_t WS_H3 = 242 * MiB;
constexpr size_t WS_BAR = 243 * MiB;
constexpr size_t WS_END = 244 * MiB;

#define LAS __attribute__((address_space(3)))
typedef unsigned short bf16;
typedef float f32x4 __attribute__((ext_vector_type(4)));
typedef unsigned u32x4 __attribute__((ext_vector_type(4)));
typedef unsigned u32x2 __attribute__((ext_vector_type(2)));
typedef short bf16x8 __attribute__((ext_vector_type(8)));
typedef short s16x4 __attribute__((ext_vector_type(4)));
#define LDS_WAIT() asm volatile("s_waitcnt lgkmcnt(0)" ::: "memory")
using pg8::cvt_pk_bf16;
__device__ __forceinline__ float bf2f(unsigned v) { return __uint_as_float(v << 16); }
__device__ __forceinline__ unsigned f2bf(float f) { return cvt_pk_bf16(f, 0.f) & 0xffffu; }
__device__ __forceinline__ float wave_sum(float v) {
#pragma unroll
    for (int o = 1; o < 64; o <<= 1) v += __shfl_xor(v, o);
    return v;
}

struct Params { const float* in[26]; float* out; unsigned char* ws; };
enum { I_X = 0, I_G1, I_WG1, I_WU1, I_WD1, I_GMIX, I_WIN, I_CW, I_CB, I_FW1, I_FB1, I_FW2, I_FB2, I_FW3, I_FB3, I_FWO, I_FREQ, I_SKIP, I_GHY, I_GAT, I_WOUT, I_G2, I_WG2, I_WU2, I_WD2, I_GFIN };

__device__ __forceinline__ void p0_transpose_item(const float* W, int K, int N, bf16* WT, int k0, int n0, int drow0, LAS float* scr, int lane) {
#pragma unroll 8
    for (int i = 0; i < 32; ++i) { const int kk = 2 * i + (lane >> 5); scr[kk * 33 + (lane & 31)] = W[(size_t)(k0 + kk) * N + n0 + (lane & 31)]; }
    LDS_WAIT();
    const int c = lane & 7;
#pragma unroll
    for (int j = 0; j < 4; ++j) { const int n = (lane >> 3) + 8 * j; const LAS float* s = scr + (8 * c) * 33 + n;
        u32x4 o; o.x = cvt_pk_bf16(s[0 * 33], s[1 * 33]); o.y = cvt_pk_bf16(s[2 * 33], s[3 * 33]); o.z = cvt_pk_bf16(s[4 * 33], s[5 * 33]); o.w = cvt_pk_bf16(s[6 * 33], s[7 * 33]);
        *(u32x4*)(WT + (size_t)(drow0 + n) * K + k0 + 8 * c) = o; }
    LDS_WAIT();
}
__device__ __forceinline__ void p0_transpose_mat(const float* W, int K, int N, bf16* WT, int mode, int item, LAS float* scr, int lane) {
    const int nblk = N / 32, kb = item / nblk, nb = item % nblk, n0 = 32 * nb;
    const int drow0 = mode == 0 ? n0 : (256 * (n0 / 128) + (n0 % 128) + (mode == 2 ? 128 : 0));
    p0_transpose_item(W, K, N, WT, 64 * kb, n0, drow0, scr, lane);
}
__device__ __forceinline__ void rms_row_to_bf16(const float* xrow, const float* g, bf16* orow, int lane) {
    const f32x4* xr = (const f32x4*)xrow + lane; const f32x4* gr = (const f32x4*)g + lane;
    f32x4 v[4]; float s = 0.f;
#pragma unroll
    for (int j = 0; j < 4; ++j) { v[j] = xr[64 * j]; s += (v[j].x * v[j].x + v[j].y * v[j].y) + (v[j].z * v[j].z + v[j].w * v[j].w); }
    const float rstd = 1.0f / sqrtf(wave_sum(s) * (1.f / D) + RMS_EPS);
    u32x2* o8 = (u32x2*)orow + lane;
#pragma unroll
    for (int j = 0; j < 4; ++j) { const f32x4 gv = gr[64 * j]; u32x2 w; w.x = cvt_pk_bf16(v[j].x * rstd * gv.x, v[j].y * rstd * gv.y); w.y = cvt_pk_bf16(v[j].z * rstd * gv.z, v[j].w * rstd * gv.w); o8[64 * j] = w; }
}
__device__ __forceinline__ void rms_row_to_f32(const float* xrow, const float* g, float* orow, int lane) {
    const f32x4* xr = (const f32x4*)xrow + lane; const f32x4* gr = (const f32x4*)g + lane;
    f32x4 v[4]; float s = 0.f;
#pragma unroll
    for (int j = 0; j < 4; ++j) { v[j] = xr[64 * j]; s += (v[j].x * v[j].x + v[j].y * v[j].y) + (v[j].z * v[j].z + v[j].w * v[j].w); }
    const float rstd = 1.0f / sqrtf(wave_sum(s) * (1.f / D) + RMS_EPS);
    f32x4* o = (f32x4*)orow + lane;
#pragma unroll
    for (int j = 0; j < 4; ++j) { const f32x4 gv = gr[64 * j]; o[64 * j] = v[j] * rstd * gv; }
}

__device__ __forceinline__ void filt_stage1(const Params& p, LAS unsigned char* lds, int tid) {
    const int wave = tid >> 6, j = tid & 63;
    LAS float* zb = (LAS float*)lds + wave * 192; LAS float* ha = zb + 64; LAS float* hb = zb + 128;
    LAS float* w1l = (LAS float*)(lds + 8192); LAS float* w2l = w1l + 33 * 64; LAS float* w3l = w2l + 64 * 64;
    float* H3 = (float*)(p.ws + WS_H3);
    for (int i = tid; i < 33 * 64; i += NWAVES * 64) w1l[i] = p.in[I_FW1][i];
    for (int i = tid; i < 64 * 64; i += NWAVES * 64) { w2l[i] = p.in[I_FW2][i]; w3l[i] = p.in[I_FW3][i]; }
    const float fq = p.in[I_FREQ][j], b1 = p.in[I_FB1][j], b2 = p.in[I_FB2][j], b3 = p.in[I_FB3][j];
    __syncthreads();
    for (int base = blockIdx.x * 8; base < SEQ; base += gridDim.x * 8) {
        const int pos = base + wave;
        const float tl = (float)pos / 2047.0f, w = (6.283185307179586f * (float)pos) / 2048.0f;
        if (j < 33) { float z; if (j == 0) z = tl; else { const int i = (j - 1) & 15; const float f = 1e-4f + (float)i * ((15.0f - 1e-4f) / 15.0f); z = (j <= 16) ? cosf(f * w) : -sinf(f * w); } zb[j] = z; }
        __syncthreads();
        { float a = b1;
#pragma unroll
          for (int i = 0; i < 33; ++i) a += zb[i] * w1l[i * 64 + j];
          ha[j] = sinf(fq * a); }
        __syncthreads();
        { float a = b2;
#pragma unroll
          for (int i = 0; i < 64; ++i) a += ha[i] * w2l[i * 64 + j];
          hb[j] = sinf(fq * a); }
        __syncthreads();
        { float a = b3;
#pragma unroll
          for (int i = 0; i < 64; ++i) a += hb[i] * w3l[i * 64 + j];
          H3[pos * 64 + j] = sinf(fq * a); }
        __syncthreads();
    }
}
__device__ __forceinline__ void filt_stage2(const Params& p, LAS unsigned char* lds, int tid) {
    LAS float* wl = (LAS float*)lds;
    const float* H3 = (const float*)(p.ws + WS_H3); bf16* G = (bf16*)(p.ws + WS_G);
    const int e = tid & 7, ps = tid >> 3;
    for (int cb = blockIdx.x; cb < 256; cb += gridDim.x) {
        const int col = 8 * cb + e, o = col >> 10, dir = (col >> 9) & 1, c = col & 511;
        __syncthreads();
        wl[(tid & 7) * 64 + (tid >> 3)] = p.in[I_FWO][(size_t)(tid >> 3) * 2048 + 8 * cb + (tid & 7)];
        __syncthreads();
        const float ad = 3.0701134573253943f + (float)c * ((15.350567286626972f - 3.0701134573253943f) / 511.0f);
        bf16* gp = G + (size_t)(c * 2 + o) * 4096;
        const LAS f32x4* wv = (const LAS f32x4*)(wl + e * 64);
#pragma unroll 1
        for (int k = 0; k < 32; ++k) {
            const int pos = 64 * k + ps; const f32x4* hr = (const f32x4*)(H3 + (size_t)pos * 64);
            float acc = 0.f;
#pragma unroll
            for (int q = 0; q < 16; ++q) { const f32x4 hv = hr[q], w4 = wv[q]; acc += (hv.x * w4.x + hv.y * w4.y) + (hv.z * w4.z + hv.w * w4.w); }
            const float val = acc * expf(-((float)pos / 2047.0f) * ad);
            if (dir == 0) gp[2048 + pos] = (bf16)f2bf(val); else if (pos > 0) gp[2048 - pos] = (bf16)f2bf(val); else gp[0] = 0;
        }
    }
    __syncthreads();
}

__device__ __forceinline__ float sconv(const bf16* row, int t, float w0, float w1, float w2, float bias) {
    float a = bias + w1 * bf2f(row[t]);
    if (t > 0) a += w0 * bf2f(row[t - 1]);
    if (t < SEQ - 1) a += w2 * bf2f(row[t + 1]);
    return a;
}
__device__ __forceinline__ void conv_unit_scalar(const Params& p, LAS unsigned char* lds, int c, int tid) {
    LAS float* g = (LAS float*)lds;
    LAS bf16* zA = (LAS bf16*)(lds + 16384);
    LAS bf16* zB = (LAS bf16*)(lds + 16384 + 32768);
    const bf16* PT = (const bf16*)(p.ws + WS_PT); const bf16* G = (const bf16*)(p.ws + WS_G); bf16* YHT = (bf16*)(p.ws + WS_YHT);
    const float* cw = p.in[I_CW]; const float* cb = p.in[I_CB];
    float x1c[4][8], x2c[4][8];
    {
        const float v0 = cw[c], v1 = cw[1536 + c], v2 = cw[3072 + c], vb = cb[c];
        const float a0 = cw[512 + c], a1 = cw[1536 + 512 + c], a2 = cw[3072 + 512 + c], ab = cb[512 + c];
        const float b0 = cw[1024 + c], b1 = cw[1536 + 1024 + c], b2 = cw[3072 + 1024 + c], bb = cb[1024 + c];
#pragma unroll
        for (int k = 0; k < 4; ++k)
#pragma unroll
            for (int b = 0; b < 8; ++b) { const int t = tid + 512 * k;
                zA[b * 2048 + t] = (bf16)f2bf(sconv(PT + (size_t)c * M + b * SEQ, t, v0, v1, v2, vb));
                x1c[k][b] = sconv(PT + (size_t)(512 + c) * M + b * SEQ, t, a0, a1, a2, ab);
                x2c[k][b] = sconv(PT + (size_t)(1024 + c) * M + b * SEQ, t, b0, b1, b2, bb); }
    }
    for (int o = 0; o < 2; ++o) {
        __syncthreads();
#pragma unroll
        for (int e = 0; e < 8; ++e) { const int idx = tid + 512 * e; g[idx] = bf2f(G[(size_t)(c * 2 + o) * 4096 + idx]); }
        __syncthreads();
        const LAS bf16* zin = o ? zB : zA;
        float acc[4][8];
#pragma unroll
        for (int k = 0; k < 4; ++k)
#pragma unroll
            for (int b = 0; b < 8; ++b) acc[k][b] = 0.f;
        for (int s = 0; s < SEQ; ++s) {
            float zv[8];
#pragma unroll
            for (int b = 0; b < 8; ++b) zv[b] = bf2f(zin[b * 2048 + s]);
#pragma unroll
            for (int k = 0; k < 4; ++k) { const float gv = g[2048 + tid + 512 * k - s];
#pragma unroll
                for (int b = 0; b < 8; ++b) acc[k][b] += gv * zv[b]; }
        }
        const float skip = p.in[I_SKIP][o * 512 + c];
#pragma unroll
        for (int k = 0; k < 4; ++k)
#pragma unroll
            for (int b = 0; b < 8; ++b) { const int t = tid + 512 * k; const float y = acc[k][b] + bf2f(zin[b * 2048 + t]) * skip;
                if (o == 0) zB[b * 2048 + t] = (bf16)f2bf(x1c[k][b] * y); else YHT[(size_t)c * M + b * SEQ + t] = (bf16)f2bf(x2c[k][b] * y); }
    }
    __syncthreads();
}
#define XB_TMO      128
#define XB_XCNT(j)  (256  + 64 * (j))
#define XB_XSUB(j)  (1280 + 64 * (j))
#define XB_XGEN(j)  (2304 + 64 * (j))
#define XB_TOP      3328
#define XB_TOPGEN   3392
#define XCD_BAR_WORDS 3456
#define XB_SPIN_CAP (1u << 18)

__device__ __forceinline__ unsigned xb_ld(unsigned* p)              { return __hip_atomic_load(p, __ATOMIC_RELAXED, __HIP_MEMORY_SCOPE_AGENT); }
__device__ __forceinline__ unsigned xb_add(unsigned* p, unsigned v) { return __hip_atomic_fetch_add(p, v, __ATOMIC_RELAXED, __HIP_MEMORY_SCOPE_AGENT); }
__device__ __forceinline__ unsigned xb_xcc_id() { return (unsigned)__builtin_amdgcn_s_getreg((3 << 11) | 20) & 0xFu; }
#define XB_SPIN(cond, bar) do { unsigned _sp = 0; while (cond) { __builtin_amdgcn_s_sleep(1); \
    if ((++_sp & 255u) == 0u) { if (xb_ld(&(bar)[XB_TMO])) break; if (_sp > XB_SPIN_CAP) { atomicAdd(&(bar)[XB_TMO], 1u); break; } } } } while (0)

struct XcdBarrier {
    unsigned* bar; unsigned x;
    volatile LAS unsigned* st;
};

__device__ __forceinline__ XcdBarrier xcd_barrier_post(unsigned* bar, volatile LAS unsigned* st) {
    XcdBarrier b; b.bar = bar; b.x = xb_xcc_id(); b.st = st;
    if (threadIdx.x == 0) (void)xb_add(&bar[XB_XCNT(b.x)], 1u);
    return b;
}
__device__ __forceinline__ void xcd_barrier_complete(unsigned* bar, unsigned x, unsigned& nloc, unsigned& nx) {
    const unsigned G = gridDim.x * gridDim.y * gridDim.z;
    unsigned sum, cnt, mine, sp = 0u;
    for (;;) {
        sum = 0u; cnt = 0u; mine = 0u;
#pragma unroll
        for (unsigned j = 0; j < 16; ++j) { const unsigned c = xb_ld(&bar[XB_XCNT(j)]); sum += c; cnt += (c > 0u) ? 1u : 0u; mine = (j == x) ? c : mine; }
        if (sum == G) break;
        __builtin_amdgcn_s_sleep(1);
        if ((++sp & 255u) == 0u) { if (xb_ld(&bar[XB_TMO])) break; if (sp > XB_SPIN_CAP) { atomicAdd(&bar[XB_TMO], 1u); break; } }
    }
    nloc = mine > 0u ? mine : 1u; nx = cnt > 0u ? cnt : 1u;
}

__device__ __forceinline__ void xcd_barrier(const XcdBarrier& b) {
    asm volatile("s_waitcnt vmcnt(0)" ::: "memory");
    __syncthreads();
    if (threadIdx.x == 0) {
        unsigned* bar = b.bar;
        __builtin_amdgcn_s_waitcnt(0);
        unsigned nloc = b.st[0], nx = b.st[1];
        if (nloc == 0u) { xcd_barrier_complete(bar, b.x, nloc, nx); b.st[0] = nloc; b.st[1] = nx; }
        const unsigned old = xb_add(&bar[XB_XSUB(b.x)], 1u);
        const unsigned gen = old / nloc;
        if (old + 1u == (gen + 1u) * nloc) {
            __builtin_amdgcn_fence(__ATOMIC_RELEASE, "agent");
            asm volatile("s_waitcnt vmcnt(0)" ::: "memory");
            const unsigned og = xb_add(&bar[XB_TOP], 1u);
            const unsigned tg = og / nx;
            if (og + 1u == (tg + 1u) * nx) xb_add(&bar[XB_TOPGEN], 1u);
            else XB_SPIN(xb_ld(&bar[XB_TOPGEN]) == tg, bar);
            __builtin_amdgcn_fence(__ATOMIC_ACQUIRE, "agent");
            xb_add(&bar[XB_XGEN(b.x)], 1u);
            asm volatile("s_waitcnt vmcnt(0)" ::: "memory");
        } else {
            XB_SPIN(xb_ld(&bar[XB_XGEN(b.x)]) == gen, bar);
            __builtin_amdgcn_fence(__ATOMIC_ACQUIRE, "agent");
            asm volatile("s_waitcnt vmcnt(0)" ::: "memory");
        }
    }
    __syncthreads();
}
constexpr int CV_GCS = 8224, CV_ZA = 8 * CV_GCS, CV_ZB = CV_ZA + 66 * 512, CV_R = CV_ZB + 66 * 512;
static_assert(CV_R + 8192 <= LDS_BYTES, "conv LDS map");
__device__ __forceinline__ void conv_build_gc(LAS unsigned char* lds, int tid) {
    const LAS bf16* R = (const LAS bf16*)(lds + CV_R);
#pragma unroll
    for (int s = 0; s < 8; ++s) {
        const int i0 = 4096 + s - 8 * tid; unsigned e[8];
#pragma unroll
        for (int jj = 0; jj < 8; ++jj) { const int idx = i0 - jj; e[jj] = (idx >= 1 && idx <= 4095) ? (unsigned)R[idx] : 0u; }
        u32x4 w; w.x = e[0] | (e[1] << 16); w.y = e[2] | (e[3] << 16); w.z = e[4] | (e[5] << 16); w.w = e[6] | (e[7] << 16);
        *(LAS u32x4*)(lds + s * CV_GCS + tid * 16) = w;
    }
}
__device__ __forceinline__ void conv_mma(LAS unsigned char* lds, int zoff, int wave, int lane, f32x4 (&acc)[4][2]) {
    const int fr = lane & 15, fq = lane >> 4;
    const LAS unsigned char* ab = lds + (fr & 7) * CV_GCS + (8 * fq - 8 * (fr >> 3) + 2048) * 2;
    const LAS unsigned char* zb = lds + zoff + (fr >> 3) * 512 + (fr & 7) * 64 + fq * 16 + 512;
#pragma unroll
    for (int jt = 0; jt < 4; ++jt) { acc[jt][0] = (f32x4){0.f, 0.f, 0.f, 0.f}; acc[jt][1] = (f32x4){0.f, 0.f, 0.f, 0.f}; }
    const int Dlo = 8 * wave - 63, Dhi = (8 * wave + 7) > 63 ? 63 : (8 * wave + 7);
#pragma unroll 2
    for (int D = Dlo; D <= Dhi; ++D) {
        const bf16x8 a0 = *(const LAS bf16x8*)(ab - 64 * D), a1 = *(const LAS bf16x8*)(ab - 64 * D - 32);
#pragma unroll
        for (int jt = 0; jt < 4; ++jt) { const int Q0 = 8 * wave + 2 * jt - D;
            if (Q0 >= -1 && Q0 <= 63) { const bf16x8 bv = *(const LAS bf16x8*)(zb + Q0 * 512);
                acc[jt][0] = __builtin_amdgcn_mfma_f32_16x16x32_bf16(a0, bv, acc[jt][0], 0, 0, 0);
                acc[jt][1] = __builtin_amdgcn_mfma_f32_16x16x32_bf16(a1, bv, acc[jt][1], 0, 0, 0); } }
    }
}
__device__ __forceinline__ f32x4 sconv4(const bf16* row, int t0, float w0, float w1, float w2, float bias) {
    const u32x2 v = *(const u32x2*)(row + t0);
    const float c0 = bf2f(v.x & 0xffffu), c1 = bf2f(v.x >> 16), c2 = bf2f(v.y & 0xffffu), c3 = bf2f(v.y >> 16);
    const float pm = (t0 & (SEQ - 1)) > 0 ? bf2f(row[t0 - 1]) : 0.f, pp = (t0 & (SEQ - 1)) + 4 < SEQ ? bf2f(row[t0 + 4]) : 0.f;
    f32x4 o; o.x = bias + w0 * pm + w1 * c0 + w2 * c1; o.y = bias + w0 * c0 + w1 * c1 + w2 * c2; o.z = bias + w0 * c1 + w1 * c2 + w2 * c3; o.w = bias + w0 * c2 + w1 * c3 + w2 * pp;
    return o;
}
__device__ __forceinline__ void conv_unit_mfma(const Params& p, LAS unsigned char* lds, int c, int tid) {
    const int lane = tid & 63, wave = __builtin_amdgcn_readfirstlane(tid >> 6), fr = lane & 15, fq = lane >> 4, nb = fr >> 3, b = fr & 7;
    const bf16* PT = (const bf16*)(p.ws + WS_PT); const bf16* G = (const bf16*)(p.ws + WS_G); bf16* YHT = (bf16*)(p.ws + WS_YHT);
    const float* cw = p.in[I_CW]; const float* cb = p.in[I_CB];
    __syncthreads();
    *(LAS u32x4*)(lds + CV_R + tid * 16) = *(const u32x4*)(G + (size_t)(c * 2) * 4096 + tid * 8);
    const u32x4 g1v = *(const u32x4*)(G + (size_t)(c * 2 + 1) * 4096 + tid * 8);
    if (tid < 128) { const int q = tid & 31, which = tid >> 5; unsigned zz; asm volatile("v_mov_b32 %0, 0" : "=v"(zz));
        *(LAS u32x4*)(lds + (which & 1 ? CV_ZB : CV_ZA) + (which & 2 ? 65 * 512 : 0) + q * 16) = (u32x4){zz, zz, zz, zz}; }
    f32x4 x1c[4][2], x2c[4][2];
    {
        const float v0 = cw[c], v1 = cw[1536 + c], v2 = cw[3072 + c], vb = cb[c];
        const float a0 = cw[512 + c], a1 = cw[1536 + 512 + c], a2 = cw[3072 + 512 + c], ab = cb[512 + c];
        const float b0 = cw[1024 + c], b1 = cw[1536 + 1024 + c], b2 = cw[3072 + 1024 + c], bb = cb[1024 + c];
#pragma unroll
        for (int jt = 0; jt < 4; ++jt)
#pragma unroll
            for (int h = 0; h < 2; ++h) { const int P = 8 * wave + 2 * jt + nb, t0 = 32 * P + 16 * h + 4 * fq;
                const f32x4 v = sconv4(PT + (size_t)c * M + b * SEQ, t0, v0, v1, v2, vb);
                u32x2 w; w.x = cvt_pk_bf16(v.x, v.y); w.y = cvt_pk_bf16(v.z, v.w);
                *(LAS u32x2*)(lds + CV_ZA + (P + 1) * 512 + b * 64 + (16 * h + 4 * fq) * 2) = w;
                x1c[jt][h] = sconv4(PT + (size_t)(512 + c) * M + b * SEQ, t0, a0, a1, a2, ab);
                x2c[jt][h] = sconv4(PT + (size_t)(1024 + c) * M + b * SEQ, t0, b0, b1, b2, bb); }
    }
    for (int o = 0; o < 2; ++o) {
        __syncthreads();
        if (o == 1) { *(LAS u32x4*)(lds + CV_R + tid * 16) = g1v; __syncthreads(); }
        conv_build_gc(lds, tid);
        __syncthreads();
        f32x4 acc[4][2];
        const int zoff = o ? CV_ZB : CV_ZA;
        conv_mma(lds, zoff, wave, lane, acc);
        const float skip = p.in[I_SKIP][o * 512 + c];
#pragma unroll
        for (int jt = 0; jt < 4; ++jt)
#pragma unroll
            for (int h = 0; h < 2; ++h) { const int P = 8 * wave + 2 * jt + nb, t0 = 32 * P + 16 * h + 4 * fq;
                const u32x2 zi = *(const LAS u32x2*)(lds + zoff + (P + 1) * 512 + b * 64 + (16 * h + 4 * fq) * 2);
                f32x4 y; y.x = acc[jt][h].x + bf2f(zi.x & 0xffffu) * skip; y.y = acc[jt][h].y + bf2f(zi.x >> 16) * skip; y.z = acc[jt][h].z + bf2f(zi.y & 0xffffu) * skip; y.w = acc[jt][h].w + bf2f(zi.y >> 16) * skip;
                const f32x4 gate = o ? x2c[jt][h] : x1c[jt][h]; y = y * gate;
                u32x2 w; w.x = cvt_pk_bf16(y.x, y.y); w.y = cvt_pk_bf16(y.z, y.w);
                if (o == 0) *(LAS u32x2*)(lds + CV_ZB + (P + 1) * 512 + b * 64 + (16 * h + 4 * fq) * 2) = w;
                else *(u32x2*)(YHT + (size_t)c * M + b * SEQ + t0) = w; }
    }
}
typedef short v4i16_t __attribute__((ext_vector_type(4)));
__device__ __forceinline__ s16x4 vtr(const LAS unsigned char* p) { return __builtin_bit_cast(s16x4, __builtin_amdgcn_ds_read_tr16_b64_v4i16((LAS v4i16_t*)p)); }
constexpr int ATT_VROW = 144;
constexpr int ATT_WAVE_LDS = 32 * ATT_VROW;
constexpr int ATT_NPAIR = 23;
__device__ __forceinline__ void att_pair_params(int pi, int tq0, int& st, int& kb) {
    if (pi < 5) { st = 16; kb = tq0 - 1024 + 512 * pi; }
    else if (pi < 11) { st = 4; kb = tq0 - 256 + 128 * (pi - 5); }
    else { st = 1; kb = tq0 - 64 + 32 * (pi - 11); }
}
__device__ __forceinline__ void att_load(const bf16* QKVb, int h, int st, int kb, int lane, bf16x8 (&kf)[2][2], u32x4 (&vv)[4]) {
    const int fr = lane & 15, fq = lane >> 4;
#pragma unroll
    for (int ab = 0; ab < 2; ++ab) { int tk = kb + st * (16 * ab + fr); tk = tk < 0 ? 0 : (tk > SEQ - 1 ? SEQ - 1 : tk);
        const bf16* kp = QKVb + (size_t)tk * NQKV + 512 + h * 64 + 8 * fq;
        kf[ab][0] = *(const bf16x8*)kp; kf[ab][1] = *(const bf16x8*)(kp + 32); }
#pragma unroll
    for (int e = 0; e < 4; ++e) { int tk = kb + st * (8 * e + (lane >> 3)); tk = tk < 0 ? 0 : (tk > SEQ - 1 ? SEQ - 1 : tk);
        vv[e] = *(const u32x4*)(QKVb + (size_t)tk * NQKV + 1024 + h * 64 + (lane & 7) * 8); }
}
__device__ __forceinline__ void attn_item(const Params& p, LAS unsigned char* vl, int item, int lane) {
    const int rcls = item & 15, stile = (item >> 4) & 7, h = (item >> 7) & 7, b = item >> 10;
    const int fr = lane & 15, fq = lane >> 4;
    const bf16* QKVb = (const bf16*)(p.ws + WS_QKV) + (size_t)b * SEQ * NQKV;
    const int tq0 = 256 * stile + rcls, tq = tq0 + 16 * fr;
    bf16x8 qf[2];
    { const bf16* qp = QKVb + (size_t)tq * NQKV + h * 64 + 8 * fq; qf[0] = *(const bf16x8*)qp; qf[1] = *(const bf16x8*)(qp + 32); }
    const float LOG2E = 1.4426950408889634f, NEG = -1e30f;
    const float slope2 = __builtin_amdgcn_exp2f(-(float)(h + 1)) * LOG2E, sc2 = 0.125f * LOG2E;
    float m = NEG, lpart = 0.f; f32x4 oacc[4];
#pragma unroll
    for (int mt = 0; mt < 4; ++mt) oacc[mt] = (f32x4){0.f, 0.f, 0.f, 0.f};
    bf16x8 kf[2][2], kfn[2][2]; u32x4 vv[4], vvn[4];
    int st, kb; att_pair_params(0, tq0, st, kb); att_load(QKVb, h, st, kb, lane, kf, vv);
    for (int pi = 0; pi < ATT_NPAIR; ++pi) {
        int stn = st, kbn = kb;
        if (pi + 1 < ATT_NPAIR) { att_pair_params(pi + 1, tq0, stn, kbn); att_load(QKVb, h, stn, kbn, lane, kfn, vvn); }
        f32x4 s[2];
#pragma unroll
        for (int ab = 0; ab < 2; ++ab) { s[ab] = (f32x4){0.f, 0.f, 0.f, 0.f};
            s[ab] = __builtin_amdgcn_mfma_f32_16x16x32_bf16(kf[ab][0], qf[0], s[ab], 0, 0, 0);
            s[ab] = __builtin_amdgcn_mfma_f32_16x16x32_bf16(kf[ab][1], qf[1], s[ab], 0, 0, 0); }
        float sv[8]; float mx = NEG;
#pragma unroll
        for (int ab = 0; ab < 2; ++ab)
#pragma unroll
            for (int r = 0; r < 4; ++r) { const int tk = kb + st * (16 * ab + 4 * fq + r); const int dl = tk - tq, adl = dl < 0 ? -dl : dl;
                const bool valid = ((unsigned)tk < (unsigned)SEQ) && (adl <= 64 * st);
                const float x = s[ab][r] * sc2 - slope2 * (float)adl; sv[ab * 4 + r] = valid ? x : NEG; mx = fmaxf(mx, sv[ab * 4 + r]); }
        mx = fmaxf(mx, __shfl_xor(mx, 16)); mx = fmaxf(mx, __shfl_xor(mx, 32));
        const float mnew = fmaxf(m, mx), alpha = __builtin_amdgcn_exp2f(m - mnew); m = mnew;
        float pv[8], ps = 0.f;
#pragma unroll
        for (int i = 0; i < 8; ++i) { pv[i] = sv[i] > -1e29f ? __builtin_amdgcn_exp2f(sv[i] - mnew) : 0.f; ps += pv[i]; }
        lpart = lpart * alpha + ps;
#pragma unroll
        for (int mt = 0; mt < 4; ++mt) oacc[mt] = oacc[mt] * alpha;
        u32x4 pw; pw.x = cvt_pk_bf16(pv[0], pv[1]); pw.y = cvt_pk_bf16(pv[2], pv[3]); pw.z = cvt_pk_bf16(pv[4], pv[5]); pw.w = cvt_pk_bf16(pv[6], pv[7]);
        const bf16x8 pb = __builtin_bit_cast(bf16x8, pw);
        asm volatile("" ::: "memory");
#pragma unroll
        for (int e = 0; e < 4; ++e) *(LAS u32x4*)(vl + (8 * e + (lane >> 3)) * ATT_VROW + (lane & 7) * 16) = vv[e];
        LDS_WAIT();
        const LAS unsigned char* va = vl + (4 * fq + (fr >> 2)) * ATT_VROW + (fr & 3) * 8;
#pragma unroll
        for (int mt = 0; mt < 4; ++mt) { const s16x4 lo = vtr(va + mt * 32), hi = vtr(va + 16 * ATT_VROW + mt * 32);
            const bf16x8 vf = (bf16x8){lo[0], lo[1], lo[2], lo[3], hi[0], hi[1], hi[2], hi[3]};
            oacc[mt] = __builtin_amdgcn_mfma_f32_16x16x32_bf16(vf, pb, oacc[mt], 0, 0, 0); }
        LDS_WAIT();
        st = stn; kb = kbn;
#pragma unroll
        for (int ab = 0; ab < 2; ++ab) { kf[ab][0] = kfn[ab][0]; kf[ab][1] = kfn[ab][1]; }
#pragma unroll
        for (int e = 0; e < 4; ++e) vv[e] = vvn[e];
    }
    float l = lpart; l += __shfl_xor(l, 16); l += __shfl_xor(l, 32);
    const float inv = 1.0f / l;
    bf16* yp = (bf16*)(p.ws + WS_YA) + (size_t)(b * SEQ + tq) * DH + h * 64 + 4 * fq;
#pragma unroll
    for (int mt = 0; mt < 4; ++mt) { u32x2 w; w.x = cvt_pk_bf16(oacc[mt][0] * inv, oacc[mt][1] * inv); w.y = cvt_pk_bf16(oacc[mt][2] * inv, oacc[mt][3] * inv); *(u32x2*)(yp + 16 * mt) = w; }
}

__device__ __forceinline__ void mixnorm_unit(const Params& p, LAS unsigned char* lds, int unit, int tid) {
    constexpr int RS = 136;
    const int m0 = unit * 64, lane = tid & 63, wave = tid >> 6;
    const bf16* YHT = (const bf16*)(p.ws + WS_YHT); const bf16* YA = (const bf16*)(p.ws + WS_YA); bf16* Y = (bf16*)(p.ws + WS_Y);
    __syncthreads();
    { const u32x4* src = (const u32x4*)(YHT + (size_t)tid * M + m0);
#pragma unroll
        for (int q = 0; q < 8; ++q) { const u32x4 v = src[q]; LAS unsigned* d = (LAS unsigned*)(lds + tid * RS + q * 16); d[0] = v.x; d[1] = v.y; d[2] = v.z; d[3] = v.w; } }
    __syncthreads();
    const float* ghy = p.in[I_GHY]; const float* gat = p.in[I_GAT];
    for (int k = 0; k < 8; ++k) {
        const int tok = 8 * wave + k, mrow = m0 + tok;
        float v[8]; float s = 0.f;
#pragma unroll
        for (int q = 0; q < 4; ++q) { const int c = 2 * lane + 128 * q;
            v[2 * q] = bf2f(*(const LAS bf16*)(lds + c * RS + tok * 2)); v[2 * q + 1] = bf2f(*(const LAS bf16*)(lds + (c + 1) * RS + tok * 2));
            s += v[2 * q] * v[2 * q] + v[2 * q + 1] * v[2 * q + 1]; }
        const float rstd = 1.0f / sqrtf(wave_sum(s) * (1.f / DH) + RMS_EPS);
#pragma unroll
        for (int q = 0; q < 4; ++q) { const int c = 2 * lane + 128 * q;
            *(unsigned*)(Y + (size_t)mrow * D + c) = cvt_pk_bf16(v[2 * q] * rstd * ghy[c], v[2 * q + 1] * rstd * ghy[c + 1]); }
        const u32x4 a = *(const u32x4*)(YA + (size_t)mrow * DH + 8 * lane);
        float w[8]; w[0] = bf2f(a.x & 0xffffu); w[1] = bf2f(a.x >> 16); w[2] = bf2f(a.y & 0xffffu); w[3] = bf2f(a.y >> 16); w[4] = bf2f(a.z & 0xffffu); w[5] = bf2f(a.z >> 16); w[6] = bf2f(a.w & 0xffffu); w[7] = bf2f(a.w >> 16);
        float s2 = 0.f;
#pragma unroll
        for (int e = 0; e < 8; ++e) s2 += w[e] * w[e];
        const float rstd2 = 1.0f / sqrtf(wave_sum(s2) * (1.f / DH) + RMS_EPS);
        const f32x4 g0 = *(const f32x4*)(gat + 8 * lane), g1 = *(const f32x4*)(gat + 8 * lane + 4);
        u32x4 o; o.x = cvt_pk_bf16(w[0] * rstd2 * g0.x, w[1] * rstd2 * g0.y); o.y = cvt_pk_bf16(w[2] * rstd2 * g0.z, w[3] * rstd2 * g0.w);
        o.z = cvt_pk_bf16(w[4] * rstd2 * g1.x, w[5] * rstd2 * g1.y); o.w = cvt_pk_bf16(w[6] * rstd2 * g1.z, w[7] * rstd2 * g1.w);
        *(u32x4*)(Y + (size_t)mrow * D + DH + 8 * lane) = o;
    }
}

__global__ void __launch_bounds__(NWAVES * 64, 2) fwd_kernel(Params p) {
    extern __shared__ __attribute__((aligned(16))) unsigned char lds_raw[];
    LAS unsigned char* lds = (LAS unsigned char*)lds_raw;
    cg::grid_group grid = cg::this_grid();
    const int tid = threadIdx.x, lane = tid & 63, wave = __builtin_amdgcn_readfirstlane(tid >> 6);
    const int G = gridDim.x, bx = blockIdx.x;
    const int gw = bx * NWAVES + wave, NGW = G * NWAVES;
    unsigned char* ws = p.ws;
    volatile LAS unsigned* MISC = (volatile LAS unsigned*)(lds + LDS_BYTES - 64);
    unsigned* barw = (unsigned*)(ws + WS_BAR);
    if (tid < 16) MISC[tid] = 0u;
    if (bx == 0) for (int i = tid; i < XCD_BAR_WORDS; i += NWAVES * 64) __hip_atomic_store(barw + i, 0u, __ATOMIC_RELAXED, __HIP_MEMORY_SCOPE_AGENT);
    __syncthreads();
    bf16* W1A = (bf16*)(ws + WS_W1A); bf16* W1D = (bf16*)(ws + WS_W1D); bf16* WIN = (bf16*)(ws + WS_WIN); bf16* WOUT = (bf16*)(ws + WS_WOUT);
    bf16* W2A = (bf16*)(ws + WS_W2A); bf16* W2D = (bf16*)(ws + WS_W2D); bf16* XN = (bf16*)(ws + WS_XN); bf16* HB = (bf16*)(ws + WS_H);
    bf16* PT = (bf16*)(ws + WS_PT); bf16* QKV = (bf16*)(ws + WS_QKV); bf16* Y = (bf16*)(ws + WS_Y);

    {
        LAS float* scr = (LAS float*)(lds + wave * 16384);
        constexpr int I_UP = 16 * 88, I_DN = 44 * 32, I_IN = 16 * 96, I_OUT = 16 * 32;
        constexpr int NITEMS = 2 * (2 * I_UP + I_DN) + I_IN + I_OUT;
        for (int it = gw; it < NITEMS; it += NGW) {
            int r = it;
            if (r < I_UP) { p0_transpose_mat(p.in[I_WG1], D, FF, W1A, 1, r, scr, lane); continue; } r -= I_UP;
            if (r < I_UP) { p0_transpose_mat(p.in[I_WU1], D, FF, W1A, 2, r, scr, lane); continue; } r -= I_UP;
            if (r < I_DN) { p0_transpose_mat(p.in[I_WD1], FF, D, W1D, 0, r, scr, lane); continue; } r -= I_DN;
            if (r < I_UP) { p0_transpose_mat(p.in[I_WG2], D, FF, W2A, 1, r, scr, lane); continue; } r -= I_UP;
            if (r < I_UP) { p0_transpose_mat(p.in[I_WU2], D, FF, W2A, 2, r, scr, lane); continue; } r -= I_UP;
            if (r < I_DN) { p0_transpose_mat(p.in[I_WD2], FF, D, W2D, 0, r, scr, lane); continue; } r -= I_DN;
            if (r < I_IN) { p0_transpose_mat(p.in[I_WIN], D, 3072, WIN, 0, r, scr, lane); continue; } r -= I_IN;
            p0_transpose_mat(p.in[I_WOUT], D, D, WOUT, 0, r, scr, lane);
        }
        for (int m = gw; m < M; m += NGW) rms_row_to_bf16(p.in[I_X] + (size_t)m * D, p.in[I_G1], XN + (size_t)m * D, lane);
        __syncthreads();
        filt_stage1(p, lds, tid);
    }
    grid.sync();
    const XcdBarrier bar = xcd_barrier_post(barw, MISC + 8);
    filt_stage2(p, lds, tid);
    {
        pg8::Gemm g{XN, W1A, M, 2 * FF, D, nullptr, nullptr}; pg8::StaticOrder S; S.init(M, 2 * FF, G, bx);
        pg8::EpiSwiglu E{HB, FF};
        pg8::gemm_phase<pg8::EpiSwiglu, pg8::StaticOrder, true, true>(lds, g, S, E);
    }
    xcd_barrier(bar);
    {
        pg8::Gemm g{HB, W1D, M, D, FF, nullptr, nullptr}; pg8::StaticOrder S; S.init(M, D, G, bx);
        pg8::EpiResid E{p.in[I_X], p.out, D, 0.5f};
        pg8::gemm_phase<pg8::EpiResid, pg8::StaticOrder, true, true>(lds, g, S, E);
    }
    xcd_barrier(bar);
    for (int m = gw; m < M; m += NGW) rms_row_to_bf16(p.out + (size_t)m * D, p.in[I_GMIX], XN + (size_t)m * D, lane);
    xcd_barrier(bar);
    {
        pg8::Gemm g{WIN, XN, 0, 0, D, XN, WIN + (size_t)NQKV * D}; pg8::WinOrder S; S.init(G, bx);
        pg8::EpiStore2 E{PT, M, QKV, NQKV};
        pg8::gemm_phase<pg8::EpiStore2, pg8::WinOrder, true, true>(lds, g, S, E);
    }
    xcd_barrier(bar);
    for (int c = bx; c < DH; c += G) conv_unit_mfma(p, lds, c, tid);
    __syncthreads();
    for (int it = gw; it < 8192; it += NGW) attn_item(p, lds + wave * ATT_WAVE_LDS, it, lane);
    xcd_barrier(bar);
    for (int u = bx; u < M / 64; u += G) mixnorm_unit(p, lds, u, tid);
    __syncthreads();
    xcd_barrier(bar);
    {
        pg8::Gemm g{Y, WOUT, M, D, D, nullptr, nullptr}; pg8::StaticOrder S; S.init(M, D, G, bx);
        pg8::EpiResid E{p.out, p.out, D, 1.0f};
        pg8::gemm_phase<pg8::EpiResid, pg8::StaticOrder, true, true>(lds, g, S, E);
    }
    xcd_barrier(bar);
    for (int m = gw; m < M; m += NGW) rms_row_to_bf16(p.out + (size_t)m * D, p.in[I_G2], XN + (size_t)m * D, lane);
    xcd_barrier(bar);
    {
        pg8::Gemm g{XN, W2A, M, 2 * FF, D, nullptr, nullptr}; pg8::StaticOrder S; S.init(M, 2 * FF, G, bx);
        pg8::EpiSwiglu E{HB, FF};
        pg8::gemm_phase<pg8::EpiSwiglu, pg8::StaticOrder, true, true>(lds, g, S, E);
    }
    xcd_barrier(bar);
    {
        pg8::Gemm g{HB, W2D, M, D, FF, nullptr, nullptr}; pg8::StaticOrder S; S.init(M, D, G, bx);
        pg8::EpiResid E{p.out, p.out, D, 0.5f};
        pg8::gemm_phase<pg8::EpiResid, pg8::StaticOrder, true, true>(lds, g, S, E);
    }
    xcd_barrier(bar);
    for (int m = gw; m < M; m += NGW) rms_row_to_f32(p.out + (size_t)m * D, p.in[I_GFIN], p.out + (size_t)m * D, lane);
}

extern "C" void kernel_launch(void* const* d_in, const int* in_sizes, int n_in, void* d_out, int out_size, void* d_ws, size_t ws_size, hipStream_t stream) {
    static int grid = 0;
    if (grid == 0) {
        if (n_in != 26 || in_sizes[0] != M * D || out_size != M * D || ws_size < WS_END) { fprintf(stderr, "kernel_launch: unexpected shapes (n_in %d, in0 %d, out %d, ws %zu)\n", n_in, n_in > 0 ? in_sizes[0] : -1, out_size, ws_size); grid = -1; return; }
        int dev = 0, cus = 0, per_cu = 0;
        hipGetDevice(&dev); hipDeviceGetAttribute(&cus, hipDeviceAttributeMultiprocessorCount, dev);
        if (hipFuncSetAttribute((const void*)fwd_kernel, hipFuncAttributeMaxDynamicSharedMemorySize, LDS_BYTES) != hipSuccess) { fprintf(stderr, "kernel_launch: hipFuncSetAttribute failed\n"); grid = -1; return; }
        if (hipOccupancyMaxActiveBlocksPerMultiprocessor(&per_cu, (const void*)fwd_kernel, NWAVES * 64, LDS_BYTES) != hipSuccess || per_cu < 1) { fprintf(stderr, "kernel_launch: occupancy query says %d blocks per CU\n", per_cu); (void)hipGetLastError(); grid = -1; return; }
        grid = cus;
    }
    if (grid < 0) return;
    Params prm{};
    for (int i = 0; i < 26; ++i) prm.in[i] = (const float*)d_in[i];
    prm.out = (float*)d_out; prm.ws = (unsigned char*)d_ws;
    void* args[] = {&prm};
    hipError_t e = hipLaunchCooperativeKernel((const void*)fwd_kernel, dim3(grid), dim3(NWAVES * 64), args, LDS_BYTES, stream);
    if (e != hipSuccess) fprintf(stderr, "kernel_launch: cooperative launch failed: %s (grid %d)\n", hipGetErrorString(e), grid);
}
```

```cpp
#include <hip/hip_runtime.h>
#include <hip/hip_cooperative_groups.h>
#include <cstdio>
#include <cstdint>
namespace cg = cooperative_groups;
namespace pg8 {
#define PG8_LAS __attribute__((address_space(3)))
typedef unsigned short bf16_t;
typedef short bf16x8 __attribute__((ext_vector_type(8)));
typedef float f32x4 __attribute__((ext_vector_type(4)));
typedef unsigned u32x4 __attribute__((ext_vector_type(4)));
constexpr int BM = 256, BK = 64, HALF = 128, HTB = HALF * BK * 2  , STAGE_BYTES = 8 * HTB, NXCD = 8, WGM = 8;

__host__ __device__ __forceinline__ int lds_byte(int r, int c) { const int st = (r >> 4) * 2 + (c >> 5), rr = r & 15, cc = c & 31, ob = rr * 64 + cc * 2; return st * 1024 + (ob ^ (((ob >> 9) & 1) << 5)); }
__host__ __device__ __forceinline__ void stage_rc(int b, int& R, int& C) { const int st = b / 1024, sb = b % 1024, swz = sb ^ (((sb >> 9) & 1) << 5); R = (st >> 1) * 16 + swz / 64; C = (st & 1) * 32 + (swz % 64) / 2; }
__host__ __device__ __forceinline__ int perm32(int rho) { const int n = rho >> 4, i = rho & 15; return 8 * (i >> 2) + 4 * n + (i & 3); }

struct Unit { int pm, pn, z; };
struct Gemm { const bf16_t* A; const bf16_t* Bt; int M, N, K; const bf16_t* A2; const bf16_t* Bt2; };

struct StaticOrder {
    int nM, nN, nwg, G, c;
    __host__ __device__ void init(int M, int N, int G_, int c_) { nM = M / BM; nN = N / BM; nwg = nM * nN; G = G_; c = c_; }
    __host__ __device__ bool next(int i, Unit& u) const {
        const long L = (long)i * G + c; if (L >= nwg) return false;
        int wgid = (int)L; { const int q = nwg / NXCD, r = nwg % NXCD, xcd = wgid % NXCD, off = wgid / NXCD; wgid = (xcd < r ? xcd * (q + 1) : r * (q + 1) + (xcd - r) * q) + off; }
        const int nig = WGM * nN, gid = wgid / nig, fm = gid * WGM, gsz = (nM - fm) < WGM ? (nM - fm) : WGM;
        u.pm = fm + ((wgid % nig) % gsz); u.pn = (wgid % nig) / gsz; u.z = 0; return true;
    }
    __device__ __forceinline__ void a_ready(const Unit&) const {}
    __device__ __forceinline__ void done(const Unit&) const {}
};

__device__ __forceinline__ unsigned cvt_pk_bf16(float lo, float hi) { unsigned r; asm volatile("v_cvt_pk_bf16_f32 %0, %1, %2" : "=v"(r) : "v"(lo), "v"(hi)); return r; }
typedef float f32x2 __attribute__((ext_vector_type(2)));
__device__ __forceinline__ f32x2 gelu_pk(f32x2 v) {
    const f32x2 av = __builtin_elementwise_abs(v), d = av * 0.2316418882f + 1.0f;
    f32x2 t; t.x = __builtin_amdgcn_rcpf(d.x); t.y = __builtin_amdgcn_rcpf(d.y);
    f32x2 q = t * 0.5307027145f + (-0.7265760135f); q = q * t + 0.7107068705f; q = q * t + (-0.142248368f); q = q * t + 0.127414796f; q = q * t;
    const f32x2 s = (v * v) * (-0.72134752044f);
    f32x2 e; e.x = __builtin_amdgcn_exp2f(s.x); e.y = __builtin_amdgcn_exp2f(s.y);
    const f32x2 m = v * (q * e), r = v - m;
    f32x2 o; o.x = v.x < 0.f ? m.x : r.x; o.y = v.y < 0.f ? m.y : r.y; return o;
}

struct EpiSwiglu {
    static constexpr bool PERM = true, AFTER_DRAIN = false;
    bf16_t* H; int ldh;
    __device__ __forceinline__ void operator()(const f32x4 (&acc)[2][2][4][2], const Unit& u, int wr, int wc, int fr, int fq) const {
        const int row0 = u.pm * BM + wr * 64 + fr, col0 = u.pn * HALF + wc * 32 + 8 * fq;
#pragma unroll
        for (int ai = 0; ai < 2; ++ai)
#pragma unroll
            for (int m = 0; m < 4; ++m) { bf16_t* rowp = H + (size_t)(row0 + ai * HALF + m * 16) * ldh + col0;
                float o[8];
#pragma unroll
                for (int n = 0; n < 2; ++n)
#pragma unroll
                    for (int e = 0; e < 4; ++e) { const float g = acc[ai][0][m][n][e], up = acc[ai][1][m][n][e];
                        const float sg = g * __builtin_amdgcn_rcpf(1.0f + __builtin_amdgcn_exp2f(-1.4426950408889634f * g)); o[n * 4 + e] = sg * up; }
                u32x4 w; w.x = cvt_pk_bf16(o[0], o[1]); w.y = cvt_pk_bf16(o[2], o[3]); w.z = cvt_pk_bf16(o[4], o[5]); w.w = cvt_pk_bf16(o[6], o[7]);
                *(u32x4*)rowp = w; }
    }
};
struct EpiResid {
    static constexpr bool PERM = false, AFTER_DRAIN = false;
    const float* base; float* out; int ldc; float scale;
    __device__ __forceinline__ void operator()(const f32x4 (&acc)[2][2][4][2], const Unit& u, int wr, int wc, int fr, int fq) const {
        const int row0 = u.pm * BM + wr * 64 + fr, col0 = u.pn * BM + wc * 32 + 4 * fq;
#pragma unroll
        for (int ai = 0; ai < 2; ++ai)
#pragma unroll
            for (int m = 0; m < 4; ++m) { const size_t off = (size_t)(row0 + ai * HALF + m * 16) * ldc + col0;
#pragma unroll
                for (int bj = 0; bj < 2; ++bj)
#pragma unroll
                    for (int n = 0; n < 2; ++n) { const f32x4 bs = *(const f32x4*)(base + off + bj * HALF + n * 16);
                        *(f32x4*)(out + off + bj * HALF + n * 16) = bs + acc[ai][bj][m][n] * scale; } }
    }
};
struct EpiStore2 {
    static constexpr bool PERM = true, AFTER_DRAIN = false;
    bf16_t* O0; int ld0; bf16_t* O1; int ld1;
    __device__ __forceinline__ void operator()(const f32x4 (&acc)[2][2][4][2], const Unit& u, int wr, int wc, int fr, int fq) const {
        bf16_t* O = u.z ? O1 : O0; const int ldc = u.z ? ld1 : ld0;
        const int row0 = u.pm * BM + wr * 64 + fr, col0 = u.pn * BM + wc * 32 + 8 * fq;
#pragma unroll
        for (int ai = 0; ai < 2; ++ai)
#pragma unroll
            for (int m = 0; m < 4; ++m) { bf16_t* rowp = O + (size_t)(row0 + ai * HALF + m * 16) * ldc + col0;
#pragma unroll
                for (int bj = 0; bj < 2; ++bj) { const f32x4 v0 = acc[ai][bj][m][0], v1 = acc[ai][bj][m][1];
                    u32x4 w; w.x = cvt_pk_bf16(v0[0], v0[1]); w.y = cvt_pk_bf16(v0[2], v0[3]); w.z = cvt_pk_bf16(v1[0], v1[1]); w.w = cvt_pk_bf16(v1[2], v1[3]);
                    *(u32x4*)(rowp + bj * HALF) = w; } }
    }
};
struct WinOrder {
    StaticOrder so;
    __host__ __device__ void init(int G_, int c_) { so.init(64 * BM, 12 * BM, G_, c_); }
    __host__ __device__ bool next(int i, Unit& u) const {
        Unit v; if (!so.next(i, v)) return false;
        if (v.pn < 6) { u.pm = v.pn; u.pn = v.pm; u.z = 0; } else { u.pm = v.pm; u.pn = v.pn - 6; u.z = 1; }
        return true;
    }
    __device__ __forceinline__ void a_ready(const Unit&) const {}
    __device__ __forceinline__ void done(const Unit&) const {}
};
template <class Epi, class Sched, bool ALIGN_EPI = false, bool SP2 = false>
__device__ __forceinline__ void gemm_phase(PG8_LAS unsigned char* lds, const Gemm g, const Sched& S, const Epi& E) {
    int tid_ = threadIdx.x; asm volatile("" : "+v"(tid_));
    const int tid = tid_, wid = __builtin_amdgcn_readfirstlane(tid >> 6), lane = tid & 63, wr = wid >> 2, wc = wid & 3, fr = lane & 15, fq = lane >> 4;
    const int K = g.K, nt = K / BK;
    unsigned voffA[2], voffB[2];
#pragma unroll
    for (int i = 0; i < 2; ++i) { int R, C; stage_rc(tid * 16 + i * 8192, R, C); const int Rb = Epi::PERM ? ((R & ~31) + perm32(R & 31)) : R;
        voffA[i] = (unsigned)(R * K + C) * 2u; voffB[i] = (unsigned)(Rb * K + C) * 2u; }
    const size_t kstep = (size_t)(BK * 2);
    const size_t hstep = (size_t)HALF * K * 2;
    const size_t tstep = 2 * hstep;
    const unsigned ldsw = (unsigned)wid * 1024u;
    const int aoff = lds_byte(wr * 64 + fr, fq * 8), boff = lds_byte(wc * 32 + fr, fq * 8);
#define PG8_SA(b, h) (((b) * 2 + (h)) * HTB)
#define PG8_SB(b, h) ((4 + (b) * 2 + (h)) * HTB)
#define PG8_STAGE(bufoff, gbase, voff) do { _Pragma("unroll") for (int _i = 0; _i < 2; ++_i) \
        __builtin_amdgcn_global_load_lds((const unsigned*)((const char*)(gbase) + (voff)[_i]), (PG8_LAS unsigned*)(lds + (bufoff) + ldsw + _i * 8192), 16, 0, 0); } while (0)
#define PG8_LDA(dst, b, h) do { _Pragma("unroll") for (int m = 0; m < 4; ++m) _Pragma("unroll") for (int k = 0; k < 2; ++k) dst[m][k] = *(const PG8_LAS bf16x8*)(lds + PG8_SA(b, h) + aoff + m * 2048 + k * 1024); } while (0)
#define PG8_LDB(dst, b, h) do { _Pragma("unroll") for (int n = 0; n < 2; ++n) _Pragma("unroll") for (int k = 0; k < 2; ++k) dst[n][k] = *(const PG8_LAS bf16x8*)(lds + PG8_SB(b, h) + boff + n * 2048 + k * 1024); } while (0)
#define PG8_MMA(ai, bj, At, Bt) do { __builtin_amdgcn_s_setprio(1); _Pragma("unroll") for (int m = 0; m < 4; ++m) _Pragma("unroll") for (int n = 0; n < 2; ++n) _Pragma("unroll") for (int k = 0; k < 2; ++k) \
        acc[ai][bj][m][n] = __builtin_amdgcn_mfma_f32_16x16x32_bf16(Bt[n][k], At[m][k], acc[ai][bj][m][n], 0, 0, 0); __builtin_amdgcn_s_setprio(0); } while (0)
#define PG8_WAIT_V(n) asm volatile("s_waitcnt vmcnt(" #n ")" ::: "memory")
#define PG8_WAIT_L(n) asm volatile("s_waitcnt lgkmcnt(" #n ")" ::: "memory")
#define PG8_BAR __builtin_amdgcn_s_barrier()
#define PG8_SCHED __builtin_amdgcn_sched_barrier(0)
    Unit cur, nxt; int ui = 0;
    if (!S.next(0, cur)) return;
    f32x4 acc[2][2][4][2];
#pragma unroll
    for (int a = 0; a < 2; ++a)
#pragma unroll
        for (int b = 0; b < 2; ++b)
#pragma unroll
            for (int m = 0; m < 4; ++m)
#pragma unroll
                for (int n = 0; n < 2; ++n) acc[a][b][m][n] = (f32x4){0.f, 0.f, 0.f, 0.f};
    bf16x8 At[4][2], B0[2][2], B1[2][2];
    const char* cA = (const char*)(cur.z ? g.A2 : g.A) + (size_t)cur.pm * tstep; const char* cB = (const char*)(cur.z ? g.Bt2 : g.Bt) + (size_t)cur.pn * tstep;
    S.a_ready(cur);
    if constexpr (SP2) {
        PG8_STAGE(PG8_SB(0, 0), cB, voffB); PG8_STAGE(PG8_SB(0, 1), cB + hstep, voffB); PG8_STAGE(PG8_SA(0, 0), cA, voffA); PG8_STAGE(PG8_SA(0, 1), cA + hstep, voffA);
        if (wr == 1) PG8_BAR;
        PG8_WAIT_V(2); PG8_BAR;
        PG8_STAGE(PG8_SB(1, 0), cB + kstep, voffB); PG8_STAGE(PG8_SA(1, 0), cA + kstep, voffA); PG8_STAGE(PG8_SB(1, 1), cB + hstep + kstep, voffB);
        PG8_WAIT_V(6); PG8_BAR;
    } else {
        PG8_STAGE(PG8_SB(0, 0), cB, voffB); PG8_STAGE(PG8_SA(0, 0), cA, voffA); PG8_STAGE(PG8_SB(0, 1), cB + hstep, voffB); PG8_STAGE(PG8_SA(0, 1), cA + hstep, voffA);
        if (wr == 1) PG8_BAR;
        PG8_WAIT_V(4); PG8_BAR;
        PG8_STAGE(PG8_SB(1, 0), cB + kstep, voffB); PG8_STAGE(PG8_SA(1, 0), cA + kstep, voffA); PG8_STAGE(PG8_SB(1, 1), cB + hstep + kstep, voffB);
        PG8_WAIT_V(6); PG8_BAR;
    }
    for (;;) {
        const bool has_next = S.next(ui + 1, nxt);
        const char* nA = has_next ? (const char*)(nxt.z ? g.A2 : g.A) + (size_t)nxt.pm * tstep : cA; const char* nB = has_next ? (const char*)(nxt.z ? g.Bt2 : g.Bt) + (size_t)nxt.pn * tstep : cB;
        for (int t = 0; t < nt; t += 2) {
            const bool last = (t == nt - 2);
            const char* a1 = cA + (size_t)(t + 1) * kstep;
            const char* a2 = last ? nA : cA + (size_t)(t + 2) * kstep; const char* b2 = last ? nB : cB + (size_t)(t + 2) * kstep;
            const char* a3 = a2 + kstep; const char* b3 = b2 + kstep;
            if (last && has_next) S.a_ready(nxt);
            if constexpr (SP2) {
            PG8_LDB(B0, 0, 0); PG8_LDB(B1, 0, 1); PG8_SCHED; PG8_LDA(At, 0, 0); PG8_STAGE(PG8_SA(1, 1), a1 + hstep, voffA);
            PG8_WAIT_V(8); PG8_WAIT_L(0); PG8_BAR; PG8_MMA(0, 0, At, B0); PG8_MMA(0, 1, At, B1); PG8_BAR; PG8_SCHED;
            PG8_LDA(At, 0, 1); PG8_STAGE(PG8_SB(0, 0), b2, voffB); PG8_STAGE(PG8_SB(0, 1), b2 + hstep, voffB); PG8_STAGE(PG8_SA(0, 0), a2, voffA);
            PG8_WAIT_V(8); PG8_WAIT_L(0); PG8_BAR; PG8_MMA(1, 0, At, B0); PG8_MMA(1, 1, At, B1); PG8_BAR; PG8_SCHED;
            PG8_LDB(B0, 1, 0); PG8_LDB(B1, 1, 1); PG8_SCHED; PG8_LDA(At, 1, 0); PG8_STAGE(PG8_SA(0, 1), a2 + hstep, voffA);
            PG8_WAIT_V(8); PG8_WAIT_L(0); PG8_BAR; PG8_MMA(0, 0, At, B0); PG8_MMA(0, 1, At, B1); PG8_BAR; PG8_SCHED;
            PG8_LDA(At, 1, 1); PG8_STAGE(PG8_SB(1, 0), b3, voffB); PG8_STAGE(PG8_SB(1, 1), b3 + hstep, voffB); PG8_STAGE(PG8_SA(1, 0), a3, voffA);
            PG8_WAIT_V(8); PG8_WAIT_L(0); PG8_BAR; PG8_MMA(1, 0, At, B0); PG8_MMA(1, 1, At, B1); PG8_BAR; PG8_SCHED;
            } else {
            PG8_LDB(B0, 0, 0); PG8_SCHED; PG8_LDA(At, 0, 0); PG8_STAGE(PG8_SA(1, 1), a1 + hstep, voffA);
            PG8_WAIT_L(8); PG8_BAR; PG8_WAIT_L(0); PG8_MMA(0, 0, At, B0); PG8_BAR; PG8_SCHED;
            PG8_LDB(B1, 0, 1); PG8_STAGE(PG8_SB(0, 0), b2, voffB);
            PG8_BAR; PG8_WAIT_L(0); PG8_MMA(0, 1, At, B1); PG8_BAR;
            PG8_LDA(At, 0, 1); PG8_STAGE(PG8_SA(0, 0), a2, voffA);
            PG8_BAR; PG8_WAIT_L(0); PG8_MMA(1, 0, At, B0); PG8_BAR; PG8_SCHED;
            PG8_STAGE(PG8_SB(0, 1), b2 + hstep, voffB);
            PG8_WAIT_V(6); PG8_BAR; PG8_MMA(1, 1, At, B1); PG8_BAR;
            PG8_LDB(B0, 1, 0); PG8_SCHED; PG8_LDA(At, 1, 0); PG8_STAGE(PG8_SA(0, 1), a2 + hstep, voffA);
            PG8_WAIT_L(8); PG8_BAR; PG8_WAIT_L(0); PG8_MMA(0, 0, At, B0); PG8_BAR; PG8_SCHED;
            PG8_LDB(B1, 1, 1); PG8_STAGE(PG8_SB(1, 0), b3, voffB);
            PG8_BAR; PG8_WAIT_L(0); PG8_MMA(0, 1, At, B1); PG8_BAR;
            PG8_LDA(At, 1, 1); PG8_STAGE(PG8_SA(1, 0), a3, voffA);
            PG8_BAR; PG8_WAIT_L(0); PG8_MMA(1, 0, At, B0); PG8_BAR; PG8_SCHED;
            PG8_STAGE(PG8_SB(1, 1), b3 + hstep, voffB);
            PG8_WAIT_V(6); PG8_BAR; PG8_MMA(1, 1, At, B1); PG8_BAR;
            }
        }
        if constexpr (ALIGN_EPI) { if (wr == 0) PG8_BAR; }
        if constexpr (!Epi::AFTER_DRAIN) { E(acc, cur, wr, wc, fr, fq); S.done(cur); }
        if (!has_next) break;
#pragma unroll
        for (int a = 0; a < 2; ++a)
#pragma unroll
            for (int b = 0; b < 2; ++b)
#pragma unroll
                for (int m = 0; m < 4; ++m)
#pragma unroll
                    for (int n = 0; n < 2; ++n) acc[a][b][m][n] = (f32x4){0.f, 0.f, 0.f, 0.f};
        cur = nxt; cA = nA; cB = nB; ++ui;
        if constexpr (ALIGN_EPI) { if (wr == 1) PG8_BAR; }
    }
    PG8_WAIT_V(0);
    if constexpr (!ALIGN_EPI) { if (wr == 0) PG8_BAR; }
    PG8_BAR;
    if constexpr (Epi::AFTER_DRAIN) { E.fused(acc, cur, wr, wc, fr, fq, lds, wid, lane); S.done(cur); }
#undef PG8_SA
#undef PG8_SB
#undef PG8_STAGE
#undef PG8_LDA
#undef PG8_LDB
#undef PG8_MMA
#undef PG8_WAIT_V
#undef PG8_WAIT_L
#undef PG8_BAR
#undef PG8_SCHED
}
}
constexpr int NWAVES = 8;
constexpr int M = 16384, D = 1024, FF = 2816, NBATCH = 8, SEQ = 2048, DH = 512, NQKV = 1536;
constexpr float RMS_EPS = 1e-6f;
constexpr int LDS_BYTES = 147456;
constexpr size_t MiB = 1u << 20;
constexpr size_t WS_W1A = 0, WS_W1D = 11 * MiB, WS_WIN = 17 * MiB, WS_WOUT = 23 * MiB, WS_W2A = 25 * MiB, WS_W2D = 36 * MiB;
constexpr size_t WS_XN = 42 * MiB;
constexpr size_t WS_H = 74 * MiB;
constexpr size_t WS_PT = 74 * MiB;
constexpr size_t WS_QKV = 122 * MiB;
constexpr size_t WS_YHT = 170 * MiB;
constexpr size_t WS_YA = 186 * MiB;
constexpr size_t WS_Y = 202 * MiB;
constexpr size_t WS_G = 234 * MiB;
constexpr size_t WS_H3 = 242 * MiB;
constexpr size_t WS_BAR = 243 * MiB;
constexpr size_t WS_END = 244 * MiB;

#define LAS __attribute__((address_space(3)))
typedef unsigned short bf16;
typedef float f32x4 __attribute__((ext_vector_type(4)));
typedef unsigned u32x4 __attribute__((ext_vector_type(4)));
typedef unsigned u32x2 __attribute__((ext_vector_type(2)));
typedef short bf16x8 __attribute__((ext_vector_type(8)));
typedef short s16x4 __attribute__((ext_vector_type(4)));
#define LDS_WAIT() asm volatile("s_waitcnt lgkmcnt(0)" ::: "memory")
using pg8::cvt_pk_bf16;
__device__ __forceinline__ float bf2f(unsigned v) { return __uint_as_float(v << 16); }
__device__ __forceinline__ unsigned f2bf(float f) { return cvt_pk_bf16(f, 0.f) & 0xffffu; }
__device__ __forceinline__ float wave_sum(float v) {
#pragma unroll
    for (int o = 1; o < 64; o <<= 1) v += __shfl_xor(v, o);
    return v;
}

struct Params { const float* in[26]; float* out; unsigned char* ws; };
enum { I_X = 0, I_G1, I_WG1, I_WU1, I_WD1, I_GMIX, I_WIN, I_CW, I_CB, I_FW1, I_FB1, I_FW2, I_FB2, I_FW3, I_FB3, I_FWO, I_FREQ, I_SKIP, I_GHY, I_GAT, I_WOUT, I_G2, I_WG2, I_WU2, I_WD2, I_GFIN };

__device__ __forceinline__ void p0_transpose_item(const float* W, int K, int N, bf16* WT, int k0, int n0, int drow0, LAS float* scr, int lane) {
#pragma unroll 8
    for (int i = 0; i < 32; ++i) { const int kk = 2 * i + (lane >> 5); scr[kk * 33 + (lane & 31)] = W[(size_t)(k0 + kk) * N + n0 + (lane & 31)]; }
    LDS_WAIT();
    const int c = lane & 7;
#pragma unroll
    for (int j = 0; j < 4; ++j) { const int n = (lane >> 3) + 8 * j; const LAS float* s = scr + (8 * c) * 33 + n;
        u32x4 o; o.x = cvt_pk_bf16(s[0 * 33], s[1 * 33]); o.y = cvt_pk_bf16(s[2 * 33], s[3 * 33]); o.z = cvt_pk_bf16(s[4 * 33], s[5 * 33]); o.w = cvt_pk_bf16(s[6 * 33], s[7 * 33]);
        *(u32x4*)(WT + (size_t)(drow0 + n) * K + k0 + 8 * c) = o; }
    LDS_WAIT();
}
__device__ __forceinline__ void p0_transpose_mat(const float* W, int K, int N, bf16* WT, int mode, int item, LAS float* scr, int lane) {
    const int nblk = N / 32, kb = item / nblk, nb = item % nblk, n0 = 32 * nb;
    const int drow0 = mode == 0 ? n0 : (256 * (n0 / 128) + (n0 % 128) + (mode == 2 ? 128 : 0));
    p0_transpose_item(W, K, N, WT, 64 * kb, n0, drow0, scr, lane);
}
__device__ __forceinline__ void rms_row_to_bf16(const float* xrow, const float* g, bf16* orow, int lane) {
    const f32x4* xr = (const f32x4*)xrow + lane; const f32x4* gr = (const f32x4*)g + lane;
    f32x4 v[4]; float s = 0.f;
#pragma unroll
    for (int j = 0; j < 4; ++j) { v[j] = xr[64 * j]; s += (v[j].x * v[j].x + v[j].y * v[j].y) + (v[j].z * v[j].z + v[j].w * v[j].w); }
    const float rstd = 1.0f / sqrtf(wave_sum(s) * (1.f / D) + RMS_EPS);
    u32x2* o8 = (u32x2*)orow + lane;
#pragma unroll
    for (int j = 0; j < 4; ++j) { const f32x4 gv = gr[64 * j]; u32x2 w; w.x = cvt_pk_bf16(v[j].x * rstd * gv.x, v[j].y * rstd * gv.y); w.y = cvt_pk_bf16(v[j].z * rstd * gv.z, v[j].w * rstd * gv.w); o8[64 * j] = w; }
}
__device__ __forceinline__ void rms_row_to_f32(const float* xrow, const float* g, float* orow, int lane) {
    const f32x4* xr = (const f32x4*)xrow + lane; const f32x4* gr = (const f32x4*)g + lane;
    f32x4 v[4]; float s = 0.f;
#pragma unroll
    for (int j = 0; j < 4; ++j) { v[j] = xr[64 * j]; s += (v[j].x * v[j].x + v[j].y * v[j].y) + (v[j].z * v[j].z + v[j].w * v[j].w); }
    const float rstd = 1.0f / sqrtf(wave_sum(s) * (1.f / D) + RMS_EPS);
    f32x4* o = (f32x4*)orow + lane;
#pragma unroll
    for (int j = 0; j < 4; ++j) { const f32x4 gv = gr[64 * j]; o[64 * j] = v[j] * rstd * gv; }
}

__device__ __forceinline__ void filt_stage1(const Params& p, LAS unsigned char* lds, int tid) {
    const int wave = tid >> 6, j = tid & 63;
    LAS float* zb = (LAS float*)lds + wave * 192; LAS float* ha = zb + 64; LAS float* hb = zb + 128;
    LAS float* w1l = (LAS float*)(lds + 8192); LAS float* w2l = w1l + 33 * 64; LAS float* w3l = w2l + 64 * 64;
    float* H3 = (float*)(p.ws + WS_H3);
    for (int i = tid; i < 33 * 64; i += NWAVES * 64) w1l[i] = p.in[I_FW1][i];
    for (int i = tid; i < 64 * 64; i += NWAVES * 64) { w2l[i] = p.in[I_FW2][i]; w3l[i] = p.in[I_FW3][i]; }
    const float fq = p.in[I_FREQ][j], b1 = p.in[I_FB1][j], b2 = p.in[I_FB2][j], b3 = p.in[I_FB3][j];
    __syncthreads();
    for (int base = blockIdx.x * 8; base < SEQ; base += gridDim.x * 8) {
        const int pos = base + wave;
        const float tl = (float)pos / 2047.0f, w = (6.283185307179586f * (float)pos) / 2048.0f;
        if (j < 33) { float z; if (j == 0) z = tl; else { const int i = (j - 1) & 15; const float f = 1e-4f + (float)i * ((15.0f - 1e-4f) / 15.0f); z = (j <= 16) ? cosf(f * w) : -sinf(f * w); } zb[j] = z; }
        __syncthreads();
        { float a = b1;
#pragma unroll
          for (int i = 0; i < 33; ++i) a += zb[i] * w1l[i * 64 + j];
          ha[j] = sinf(fq * a); }
        __syncthreads();
        { float a = b2;
#pragma unroll
          for (int i = 0; i < 64; ++i) a += ha[i] * w2l[i * 64 + j];
          hb[j] = sinf(fq * a); }
        __syncthreads();
        { float a = b3;
#pragma unroll
          for (int i = 0; i < 64; ++i) a += hb[i] * w3l[i * 64 + j];
          H3[pos * 64 + j] = sinf(fq * a); }
        __syncthreads();
    }
}
__device__ __forceinline__ void filt_stage2(const Params& p, LAS unsigned char* lds, int tid) {
    LAS float* wl = (LAS float*)lds;
    const float* H3 = (const float*)(p.ws + WS_H3); bf16* G = (bf16*)(p.ws + WS_G);
    const int e = tid & 7, ps = tid >> 3;
    for (int cb = blockIdx.x; cb < 256; cb += gridDim.x) {
        const int col = 8 * cb + e, o = col >> 10, dir = (col >> 9) & 1, c = col & 511;
        __syncthreads();
        wl[(tid & 7) * 64 + (tid >> 3)] = p.in[I_FWO][(size_t)(tid >> 3) * 2048 + 8 * cb + (tid & 7)];
        __syncthreads();
        const float ad = 3.0701134573253943f + (float)c * ((15.350567286626972f - 3.0701134573253943f) / 511.0f);
        bf16* gp = G + (size_t)(c * 2 + o) * 4096;
        const LAS f32x4* wv = (const LAS f32x4*)(wl + e * 64);
#pragma unroll 1
        for (int k = 0; k < 32; ++k) {
            const int pos = 64 * k + ps; const f32x4* hr = (const f32x4*)(H3 + (size_t)pos * 64);
            float acc = 0.f;
#pragma unroll
            for (int q = 0; q < 16; ++q) { const f32x4 hv = hr[q], w4 = wv[q]; acc += (hv.x * w4.x + hv.y * w4.y) + (hv.z * w4.z + hv.w * w4.w); }
            const float val = acc * expf(-((float)pos / 2047.0f) * ad);
            if (dir == 0) gp[2048 + pos] = (bf16)f2bf(val); else if (pos > 0) gp[2048 - pos] = (bf16)f2bf(val); else gp[0] = 0;
        }
    }
    __syncthreads();
}

__device__ __forceinline__ float sconv(const bf16* row, int t, float w0, float w1, float w2, float bias) {
    float a = bias + w1 * bf2f(row[t]);
    if (t > 0) a += w0 * bf2f(row[t - 1]);
    if (t < SEQ - 1) a += w2 * bf2f(row[t + 1]);
    return a;
}
__device__ __forceinline__ void conv_unit_scalar(const Params& p, LAS unsigned char* lds, int c, int tid) {
    LAS float* g = (LAS float*)lds;
    LAS bf16* zA = (LAS bf16*)(lds + 16384);
    LAS bf16* zB = (LAS bf16*)(lds + 16384 + 32768);
    const bf16* PT = (const bf16*)(p.ws + WS_PT); const bf16* G = (const bf16*)(p.ws + WS_G); bf16* YHT = (bf16*)(p.ws + WS_YHT);
    const float* cw = p.in[I_CW]; const float* cb = p.in[I_CB];
    float x1c[4][8], x2c[4][8];
    {
        const float v0 = cw[c], v1 = cw[1536 + c], v2 = cw[3072 + c], vb = cb[c];
        const float a0 = cw[512 + c], a1 = cw[1536 + 512 + c], a2 = cw[3072 + 512 + c], ab = cb[512 + c];
        const float b0 = cw[1024 + c], b1 = cw[1536 + 1024 + c], b2 = cw[3072 + 1024 + c], bb = cb[1024 + c];
#pragma unroll
        for (int k = 0; k < 4; ++k)
#pragma unroll
            for (int b = 0; b < 8; ++b) { const int t = tid + 512 * k;
                zA[b * 2048 + t] = (bf16)f2bf(sconv(PT + (size_t)c * M + b * SEQ, t, v0, v1, v2, vb));
                x1c[k][b] = sconv(PT + (size_t)(512 + c) * M + b * SEQ, t, a0, a1, a2, ab);
                x2c[k][b] = sconv(PT + (size_t)(1024 + c) * M + b * SEQ, t, b0, b1, b2, bb); }
    }
    for (int o = 0; o < 2; ++o) {
        __syncthreads();
#pragma unroll
        for (int e = 0; e < 8; ++e) { const int idx = tid + 512 * e; g[idx] = bf2f(G[(size_t)(c * 2 + o) * 4096 + idx]); }
        __syncthreads();
        const LAS bf16* zin = o ? zB : zA;
        float acc[4][8];
#pragma unroll
        for (int k = 0; k < 4; ++k)
#pragma unroll
            for (int b = 0; b < 8; ++b) acc[k][b] = 0.f;
        for (int s = 0; s < SEQ; ++s) {
            float zv[8];
#pragma unroll
            for (int b = 0; b < 8; ++b) zv[b] = bf2f(zin[b * 2048 + s]);
#pragma unroll
            for (int k = 0; k < 4; ++k) { const float gv = g[2048 + tid + 512 * k - s];
#pragma unroll
                for (int b = 0; b < 8; ++b) acc[k][b] += gv * zv[b]; }
        }
        const float skip = p.in[I_SKIP][o * 512 + c];
#pragma unroll
        for (int k = 0; k < 4; ++k)
#pragma unroll
            for (int b = 0; b < 8; ++b) { const int t = tid + 512 * k; const float y = acc[k][b] + bf2f(zin[b * 2048 + t]) * skip;
                if (o == 0) zB[b * 2048 + t] = (bf16)f2bf(x1c[k][b] * y); else YHT[(size_t)c * M + b * SEQ + t] = (bf16)f2bf(x2c[k][b] * y); }
    }
    __syncthreads();
}
#define XB_TMO      128
#define XB_XCNT(j)  (256  + 64 * (j))
#define XB_XSUB(j)  (1280 + 64 * (j))
#define XB_XGEN(j)  (2304 + 64 * (j))
#define XB_TOP      3328
#define XB_TOPGEN   3392
#define XCD_BAR_WORDS 3456
#define XB_SPIN_CAP (1u << 18)

__device__ __forceinline__ unsigned xb_ld(unsigned* p)              { return __hip_atomic_load(p, __ATOMIC_RELAXED, __HIP_MEMORY_SCOPE_AGENT); }
__device__ __forceinline__ unsigned xb_add(unsigned* p, unsigned v) { return __hip_atomic_fetch_add(p, v, __ATOMIC_RELAXED, __HIP_MEMORY_SCOPE_AGENT); }
__device__ __forceinline__ unsigned xb_xcc_id() { return (unsigned)__builtin_amdgcn_s_getreg((3 << 11) | 20) & 0xFu; }
#define XB_SPIN(cond, bar) do { unsigned _sp = 0; while (cond) { __builtin_amdgcn_s_sleep(1); \
    if ((++_sp & 255u) == 0u) { if (xb_ld(&(bar)[XB_TMO])) break; if (_sp > XB_SPIN_CAP) { atomicAdd(&(bar)[XB_TMO], 1u); break; } } } } while (0)

struct XcdBarrier {
    unsigned* bar; unsigned x;
    volatile LAS unsigned* st;
};

__device__ __forceinline__ XcdBarrier xcd_barrier_post(unsigned* bar, volatile LAS unsigned* st) {
    XcdBarrier b; b.bar = bar; b.x = xb_xcc_id(); b.st = st;
    if (threadIdx.x == 0) (void)xb_add(&bar[XB_XCNT(b.x)], 1u);
    return b;
}
__device__ __forceinline__ void xcd_barrier_complete(unsigned* bar, unsigned x, unsigned& nloc, unsigned& nx) {
    const unsigned G = gridDim.x * gridDim.y * gridDim.z;
    unsigned sum, cnt, mine, sp = 0u;
    for (;;) {
        sum = 0u; cnt = 0u; mine = 0u;
#pragma unroll
        for (unsigned j = 0; j < 16; ++j) { const unsigned c = xb_ld(&bar[XB_XCNT(j)]); sum += c; cnt += (c > 0u) ? 1u : 0u; mine = (j == x) ? c : mine; }
        if (sum == G) break;
        __builtin_amdgcn_s_sleep(1);
        if ((++sp & 255u) == 0u) { if (xb_ld(&bar[XB_TMO])) break; if (sp > XB_SPIN_CAP) { atomicAdd(&bar[XB_TMO], 1u); break; } }
    }
    nloc = mine > 0u ? mine : 1u; nx = cnt > 0u ? cnt : 1u;
}

__device__ __forceinline__ void xcd_barrier(const XcdBarrier& b) {
    asm volatile("s_waitcnt vmcnt(0)" ::: "memory");
    __syncthreads();
    if (threadIdx.x == 0) {
        unsigned* bar = b.bar;
        __builtin_amdgcn_s_waitcnt(0);
        unsigned nloc = b.st[0], nx = b.st[1];
        if (nloc == 0u) { xcd_barrier_complete(bar, b.x, nloc, nx); b.st[0] = nloc; b.st[1] = nx; }
        const unsigned old = xb_add(&bar[XB_XSUB(b.x)], 1u);
        const unsigned gen = old / nloc;
        if (old + 1u == (gen + 1u) * nloc) {
            __builtin_amdgcn_fence(__ATOMIC_RELEASE, "agent");
            asm volatile("s_waitcnt vmcnt(0)" ::: "memory");
            const unsigned og = xb_add(&bar[XB_TOP], 1u);
            const unsigned tg = og / nx;
            if (og + 1u == (tg + 1u) * nx) xb_add(&bar[XB_TOPGEN], 1u);
            else XB_SPIN(xb_ld(&bar[XB_TOPGEN]) == tg, bar);
            __builtin_amdgcn_fence(__ATOMIC_ACQUIRE, "agent");
            xb_add(&bar[XB_XGEN(b.x)], 1u);
            asm volatile("s_waitcnt vmcnt(0)" ::: "memory");
        } else {
            XB_SPIN(xb_ld(&bar[XB_XGEN(b.x)]) == gen, bar);
            __builtin_amdgcn_fence(__ATOMIC_ACQUIRE, "agent");
            asm volatile("s_waitcnt vmcnt(0)" ::: "memory");
        }
    }
    __syncthreads();
}
constexpr int CV_GCS = 8224, CV_ZBLK = 79, CV_ZA = 8 * CV_GCS, CV_ZB = CV_ZA + CV_ZBLK * 512;
static_assert(CV_ZB + CV_ZBLK * 512 <= LDS_BYTES - 64, "conv LDS map");
__device__ __forceinline__ void conv_build_gc(LAS unsigned char* lds, int tid, const u32x4 lo, const u32x4 hi) {
    const unsigned d[8] = {lo.x, lo.y, lo.z, lo.w, hi.x, hi.y, hi.z, hi.w};
#pragma unroll
    for (int s = 0; s < 8; ++s) {
        unsigned w[4];
#pragma unroll
        for (int j = 0; j < 4; ++j) { const int x = 8 + s - 2 * j, m = x >> 1;
            if (x & 1) w[j] = __builtin_amdgcn_alignbit(d[m], d[m], 16);
            else w[j] = (d[m] & 0xffffu) | (d[m - 1] & 0xffff0000u); }
        *(LAS u32x4*)(lds + s * CV_GCS + tid * 16) = (u32x4){w[0], w[1], w[2], w[3]};
    }
}
__device__ __forceinline__ void conv_mma(LAS unsigned char* lds, int zoff, int wave, int lane, f32x4 (&acc)[4][2]) {
    const int fr = lane & 15, fq = lane >> 4;
    const int Dlo = 8 * wave - 63, Dhi = 8 * wave + 7;
    const LAS unsigned char* ap = lds + (fr & 7) * CV_GCS + (8 * fq - 8 * (fr >> 3) + 2048) * 2 - 64 * Dlo;
    const LAS unsigned char* zp = lds + zoff + ((fr >> 3) + 7 + 8 * wave - Dlo) * 512 + (fr & 7) * 64 + fq * 16;
#pragma unroll
    for (int jt = 0; jt < 4; ++jt) { acc[jt][0] = (f32x4){0.f, 0.f, 0.f, 0.f}; acc[jt][1] = (f32x4){0.f, 0.f, 0.f, 0.f}; }
    bf16x8 a0 = *(const LAS bf16x8*)ap, a1 = *(const LAS bf16x8*)(ap - 32), bv[4];
#pragma unroll
    for (int jt = 0; jt < 4; ++jt) bv[jt] = *(const LAS bf16x8*)(zp + 1024 * jt);
#pragma unroll 2
    for (int i = 0; i <= Dhi - Dlo; ++i) {
        const int in = i < Dhi - Dlo ? i + 1 : i;
        const bf16x8 na0 = *(const LAS bf16x8*)(ap - 64 * in), na1 = *(const LAS bf16x8*)(ap - 64 * in - 32);
        bf16x8 nb[4];
#pragma unroll
        for (int jt = 0; jt < 4; ++jt) nb[jt] = *(const LAS bf16x8*)(zp + 1024 * jt - 512 * in);
#pragma unroll
        for (int jt = 0; jt < 4; ++jt) {
            acc[jt][0] = __builtin_amdgcn_mfma_f32_16x16x32_bf16(a0, bv[jt], acc[jt][0], 0, 0, 0);
            acc[jt][1] = __builtin_amdgcn_mfma_f32_16x16x32_bf16(a1, bv[jt], acc[jt][1], 0, 0, 0); }
        a0 = na0; a1 = na1;
#pragma unroll
        for (int jt = 0; jt < 4; ++jt) bv[jt] = nb[jt];
    }
}
__device__ __forceinline__ f32x4 sconv4(const bf16* row, int t0, float w0, float w1, float w2, float bias) {
    const u32x2 v = *(const u32x2*)(row + t0);
    const float c0 = bf2f(v.x & 0xffffu), c1 = bf2f(v.x >> 16), c2 = bf2f(v.y & 0xffffu), c3 = bf2f(v.y >> 16);
    const float pm = t0 > 0 ? bf2f(row[t0 - 1]) : 0.f, pp = t0 + 4 < SEQ ? bf2f(row[t0 + 4]) : 0.f;
    f32x4 o; o.x = bias + w0 * pm + w1 * c0 + w2 * c1; o.y = bias + w0 * c0 + w1 * c1 + w2 * c2; o.z = bias + w0 * c1 + w1 * c2 + w2 * c3; o.w = bias + w0 * c2 + w1 * c3 + w2 * pp;
    return o;
}
__device__ __forceinline__ void conv_unit_mfma(const Params& p, LAS unsigned char* lds, int c, int tid) {
    const int lane = tid & 63, wave = __builtin_amdgcn_readfirstlane(tid >> 6), fr = lane & 15, fq = lane >> 4, nb = fr >> 3, b = fr & 7;
    const bf16* PT = (const bf16*)(p.ws + WS_PT); const bf16* G = (const bf16*)(p.ws + WS_G); bf16* YHT = (bf16*)(p.ws + WS_YHT);
    const float* cw = p.in[I_CW]; const float* cb = p.in[I_CB];
    u32x4 glo[2], ghi[2];
#pragma unroll
    for (int o = 0; o < 2; ++o) { const bf16* gp = G + (size_t)(c * 2 + o) * 4096 + 4088 - 8 * tid; glo[o] = *(const u32x4*)gp;
        if (tid > 0) ghi[o] = *(const u32x4*)(gp + 8); else { unsigned zz; asm volatile("v_mov_b32 %0, 0" : "=v"(zz)); ghi[o] = (u32x4){zz, zz, zz, zz}; } }
    __syncthreads();
    { unsigned zz; asm volatile("v_mov_b32 %0, 0" : "=v"(zz));
#pragma unroll
        for (int k = 0; k < 2; ++k) { const int q = tid + 512 * k; if (q < 960) { const int z = q >= 480, r = q - 480 * z;
            *(LAS u32x4*)(lds + (z ? CV_ZB : CV_ZA) + (r < 224 ? r * 16 : 71 * 512 + (r - 224) * 16)) = (u32x4){zz, zz, zz, zz}; } } }
    f32x4 x1c[4][2], x2c[4][2];
    {
        const float v0 = cw[c], v1 = cw[1536 + c], v2 = cw[3072 + c], vb = cb[c];
        const float a0 = cw[512 + c], a1 = cw[1536 + 512 + c], a2 = cw[3072 + 512 + c], ab = cb[512 + c];
        const float b0 = cw[1024 + c], b1 = cw[1536 + 1024 + c], b2 = cw[3072 + 1024 + c], bb = cb[1024 + c];
#pragma unroll
        for (int jt = 0; jt < 4; ++jt)
#pragma unroll
            for (int h = 0; h < 2; ++h) { const int P = 8 * wave + 2 * jt + nb, t0 = 32 * P + 16 * h + 4 * fq;
                const f32x4 v = sconv4(PT + (size_t)c * M + b * SEQ, t0, v0, v1, v2, vb);
                u32x2 w; w.x = cvt_pk_bf16(v.x, v.y); w.y = cvt_pk_bf16(v.z, v.w);
                *(LAS u32x2*)(lds + CV_ZA + (P + 7) * 512 + b * 64 + (16 * h + 4 * fq) * 2) = w;
                x1c[jt][h] = sconv4(PT + (size_t)(512 + c) * M + b * SEQ, t0, a0, a1, a2, ab);
                x2c[jt][h] = sconv4(PT + (size_t)(1024 + c) * M + b * SEQ, t0, b0, b1, b2, bb); }
    }
#pragma unroll
    for (int o = 0; o < 2; ++o) {
        if (o == 1) __syncthreads();
        conv_build_gc(lds, tid, glo[o], ghi[o]);
        __syncthreads();
        f32x4 acc[4][2];
        const int zoff = o ? CV_ZB : CV_ZA;
        conv_mma(lds, zoff, wave, lane, acc);
        const float skip = p.in[I_SKIP][o * 512 + c];
#pragma unroll
        for (int jt = 0; jt < 4; ++jt)
#pragma unroll
            for (int h = 0; h < 2; ++h) { const int P = 8 * wave + 2 * jt + nb, t0 = 32 * P + 16 * h + 4 * fq;
                const u32x2 zi = *(const LAS u32x2*)(lds + zoff + (P + 7) * 512 + b * 64 + (16 * h + 4 * fq) * 2);
                f32x4 y; y.x = acc[jt][h].x + bf2f(zi.x & 0xffffu) * skip; y.y = acc[jt][h].y + bf2f(zi.x >> 16) * skip; y.z = acc[jt][h].z + bf2f(zi.y & 0xffffu) * skip; y.w = acc[jt][h].w + bf2f(zi.y >> 16) * skip;
                const f32x4 gate = o ? x2c[jt][h] : x1c[jt][h]; y = y * gate;
                u32x2 w; w.x = cvt_pk_bf16(y.x, y.y); w.y = cvt_pk_bf16(y.z, y.w);
                if (o == 0) *(LAS u32x2*)(lds + CV_ZB + (P + 7) * 512 + b * 64 + (16 * h + 4 * fq) * 2) = w;
                else *(u32x2*)(YHT + (size_t)c * M + b * SEQ + t0) = w; }
    }
}
typedef short v4i16_t __attribute__((ext_vector_type(4)));
__device__ __forceinline__ s16x4 vtr(const LAS unsigned char* p) { return __builtin_bit_cast(s16x4, __builtin_amdgcn_ds_read_tr16_b64_v4i16((LAS v4i16_t*)p)); }
constexpr int ATT_VROW = 144;
constexpr int ATT_WAVE_LDS = 32 * ATT_VROW;
constexpr int ATT_NPAIR = 23;
__device__ __forceinline__ void att_pair_params(int pi, int tq0, int& st, int& kb) {
    if (pi < 5) { st = 16; kb = tq0 - 1024 + 512 * pi; }
    else if (pi < 11) { st = 4; kb = tq0 - 256 + 128 * (pi - 5); }
    else { st = 1; kb = tq0 - 64 + 32 * (pi - 11); }
}
__device__ __forceinline__ void att_load(const bf16* QKVb, int h, int st, int kb, int lane, bf16x8 (&kf)[2][2], u32x4 (&vv)[4]) {
    const int fr = lane & 15, fq = lane >> 4;
#pragma unroll
    for (int ab = 0; ab < 2; ++ab) { int tk = kb + st * (16 * ab + fr); tk = tk < 0 ? 0 : (tk > SEQ - 1 ? SEQ - 1 : tk);
        const bf16* kp = QKVb + (size_t)tk * NQKV + 512 + h * 64 + 8 * fq;
        kf[ab][0] = *(const bf16x8*)kp; kf[ab][1] = *(const bf16x8*)(kp + 32); }
#pragma unroll
    for (int e = 0; e < 4; ++e) { int tk = kb + st * (8 * e + (lane >> 3)); tk = tk < 0 ? 0 : (tk > SEQ - 1 ? SEQ - 1 : tk);
        vv[e] = *(const u32x4*)(QKVb + (size_t)tk * NQKV + 1024 + h * 64 + (lane & 7) * 8); }
}
__device__ __forceinline__ void attn_item(const Params& p, LAS unsigned char* vl, int item, int lane) {
    const int rcls = item & 15, stile = (item >> 4) & 7, h = (item >> 7) & 7, b = item >> 10;
    const int fr = lane & 15, fq = lane >> 4;
    const bf16* QKVb = (const bf16*)(p.ws + WS_QKV) + (size_t)b * SEQ * NQKV;
    const int tq0 = 256 * stile + rcls, tq = tq0 + 16 * fr;
    bf16x8 qf[2];
    { const bf16* qp = QKVb + (size_t)tq * NQKV + h * 64 + 8 * fq; qf[0] = *(const bf16x8*)qp; qf[1] = *(const bf16x8*)(qp + 32); }
    const float LOG2E = 1.4426950408889634f, NEG = -1e30f;
    const float slope2 = __builtin_amdgcn_exp2f(-(float)(h + 1)) * LOG2E, sc2 = 0.125f * LOG2E;
    float m = NEG, lpart = 0.f; f32x4 oacc[4];
#pragma unroll
    for (int mt = 0; mt < 4; ++mt) oacc[mt] = (f32x4){0.f, 0.f, 0.f, 0.f};
    bf16x8 kf[2][2], kfn[2][2]; u32x4 vv[4], vvn[4];
    int st, kb; att_pair_params(0, tq0, st, kb); att_load(QKVb, h, st, kb, lane, kf, vv);
    for (int pi = 0; pi < ATT_NPAIR; ++pi) {
        int stn = st, kbn = kb;
        if (pi + 1 < ATT_NPAIR) { att_pair_params(pi + 1, tq0, stn, kbn); att_load(QKVb, h, stn, kbn, lane, kfn, vvn); }
        f32x4 s[2];
#pragma unroll
        for (int ab = 0; ab < 2; ++ab) { s[ab] = (f32x4){0.f, 0.f, 0.f, 0.f};
            s[ab] = __builtin_amdgcn_mfma_f32_16x16x32_bf16(kf[ab][0], qf[0], s[ab], 0, 0, 0);
            s[ab] = __builtin_amdgcn_mfma_f32_16x16x32_bf16(kf[ab][1], qf[1], s[ab], 0, 0, 0); }
        float sv[8]; float mx = NEG;
#pragma unroll
        for (int ab = 0; ab < 2; ++ab)
#pragma unroll
            for (int r = 0; r < 4; ++r) { const int tk = kb + st * (16 * ab + 4 * fq + r); const int dl = tk - tq, adl = dl < 0 ? -dl : dl;
                const bool valid = ((unsigned)tk < (unsigned)SEQ) && (adl <= 64 * st);
                const float x = s[ab][r] * sc2 - slope2 * (float)adl; sv[ab * 4 + r] = valid ? x : NEG; mx = fmaxf(mx, sv[ab * 4 + r]); }
        mx = fmaxf(mx, __shfl_xor(mx, 16)); mx = fmaxf(mx, __shfl_xor(mx, 32));
        const float mnew = fmaxf(m, mx), alpha = __builtin_amdgcn_exp2f(m - mnew); m = mnew;
        float pv[8], ps = 0.f;
#pragma unroll
        for (int i = 0; i < 8; ++i) { pv[i] = sv[i] > -1e29f ? __builtin_amdgcn_exp2f(sv[i] - mnew) : 0.f; ps += pv[i]; }
        lpart = lpart * alpha + ps;
#pragma unroll
        for (int mt = 0; mt < 4; ++mt) oacc[mt] = oacc[mt] * alpha;
        u32x4 pw; pw.x = cvt_pk_bf16(pv[0], pv[1]); pw.y = cvt_pk_bf16(pv[2], pv[3]); pw.z = cvt_pk_bf16(pv[4], pv[5]); pw.w = cvt_pk_bf16(pv[6], pv[7]);
        const bf16x8 pb = __builtin_bit_cast(bf16x8, pw);
        asm volatile("" ::: "memory");
#pragma unroll
        for (int e = 0; e < 4; ++e) *(LAS u32x4*)(vl + (8 * e + (lane >> 3)) * ATT_VROW + (lane & 7) * 16) = vv[e];
        LDS_WAIT();
        const LAS unsigned char* va = vl + (4 * fq + (fr >> 2)) * ATT_VROW + (fr & 3) * 8;
#pragma unroll
        for (int mt = 0; mt < 4; ++mt) { const s16x4 lo = vtr(va + mt * 32), hi = vtr(va + 16 * ATT_VROW + mt * 32);
            const bf16x8 vf = (bf16x8){lo[0], lo[1], lo[2], lo[3], hi[0], hi[1], hi[2], hi[3]};
            oacc[mt] = __builtin_amdgcn_mfma_f32_16x16x32_bf16(vf, pb, oacc[mt], 0, 0, 0); }
        LDS_WAIT();
        st = stn; kb = kbn;
#pragma unroll
        for (int ab = 0; ab < 2; ++ab) { kf[ab][0] = kfn[ab][0]; kf[ab][1] = kfn[ab][1]; }
#pragma unroll
        for (int e = 0; e < 4; ++e) vv[e] = vvn[e];
    }
    float l = lpart; l += __shfl_xor(l, 16); l += __shfl_xor(l, 32);
    const float inv = 1.0f / l;
    bf16* yp = (bf16*)(p.ws + WS_YA) + (size_t)(b * SEQ + tq) * DH + h * 64 + 4 * fq;
#pragma unroll
    for (int mt = 0; mt < 4; ++mt) { u32x2 w; w.x = cvt_pk_bf16(oacc[mt][0] * inv, oacc[mt][1] * inv); w.y = cvt_pk_bf16(oacc[mt][2] * inv, oacc[mt][3] * inv); *(u32x2*)(yp + 16 * mt) = w; }
}

__device__ __forceinline__ void mixnorm_unit(const Params& p, LAS unsigned char* lds, int unit, int tid) {
    constexpr int RS = 136;
    const int m0 = unit * 64, lane = tid & 63, wave = tid >> 6;
    const bf16* YHT = (const bf16*)(p.ws + WS_YHT); const bf16* YA = (const bf16*)(p.ws + WS_YA); bf16* Y = (bf16*)(p.ws + WS_Y);
    __syncthreads();
    { const u32x4* src = (const u32x4*)(YHT + (size_t)tid * M + m0);
#pragma unroll
        for (int q = 0; q < 8; ++q) { const u32x4 v = src[q]; LAS unsigned* d = (LAS unsigned*)(lds + tid * RS + q * 16); d[0] = v.x; d[1] = v.y; d[2] = v.z; d[3] = v.w; } }
    __syncthreads();
    const float* ghy = p.in[I_GHY]; const float* gat = p.in[I_GAT];
    for (int k = 0; k < 8; ++k) {
        const int tok = 8 * wave + k, mrow = m0 + tok;
        float v[8]; float s = 0.f;
#pragma unroll
        for (int q = 0; q < 4; ++q) { const int c = 2 * lane + 128 * q;
            v[2 * q] = bf2f(*(const LAS bf16*)(lds + c * RS + tok * 2)); v[2 * q + 1] = bf2f(*(const LAS bf16*)(lds + (c + 1) * RS + tok * 2));
            s += v[2 * q] * v[2 * q] + v[2 * q + 1] * v[2 * q + 1]; }
        const float rstd = 1.0f / sqrtf(wave_sum(s) * (1.f / DH) + RMS_EPS);
#pragma unroll
        for (int q = 0; q < 4; ++q) { const int c = 2 * lane + 128 * q;
            *(unsigned*)(Y + (size_t)mrow * D + c) = cvt_pk_bf16(v[2 * q] * rstd * ghy[c], v[2 * q + 1] * rstd * ghy[c + 1]); }
        const u32x4 a = *(const u32x4*)(YA + (size_t)mrow * DH + 8 * lane);
        float w[8]; w[0] = bf2f(a.x & 0xffffu); w[1] = bf2f(a.x >> 16); w[2] = bf2f(a.y & 0xffffu); w[3] = bf2f(a.y >> 16); w[4] = bf2f(a.z & 0xffffu); w[5] = bf2f(a.z >> 16); w[6] = bf2f(a.w & 0xffffu); w[7] = bf2f(a.w >> 16);
        float s2 = 0.f;
#pragma unroll
        for (int e = 0; e < 8; ++e) s2 += w[e] * w[e];
        const float rstd2 = 1.0f / sqrtf(wave_sum(s2) * (1.f / DH) + RMS_EPS);
        const f32x4 g0 = *(const f32x4*)(gat + 8 * lane), g1 = *(const f32x4*)(gat + 8 * lane + 4);
        u32x4 o; o.x = cvt_pk_bf16(w[0] * rstd2 * g0.x, w[1] * rstd2 * g0.y); o.y = cvt_pk_bf16(w[2] * rstd2 * g0.z, w[3] * rstd2 * g0.w);
        o.z = cvt_pk_bf16(w[4] * rstd2 * g1.x, w[5] * rstd2 * g1.y); o.w = cvt_pk_bf16(w[6] * rstd2 * g1.z, w[7] * rstd2 * g1.w);
        *(u32x4*)(Y + (size_t)mrow * D + DH + 8 * lane) = o;
    }
}

__device__ __forceinline__ int launder(int v) { asm volatile("" : "+v"(v)); return v; }
__global__ void __launch_bounds__(NWAVES * 64, 2) fwd_kernel(Params p) {
    extern __shared__ __attribute__((aligned(16))) unsigned char lds_raw[];
    LAS unsigned char* lds = (LAS unsigned char*)lds_raw;
    cg::grid_group grid = cg::this_grid();
#define TID() launder((int)threadIdx.x)
#define WAVE() __builtin_amdgcn_readfirstlane((int)(threadIdx.x >> 6))
#define GW() (bx * NWAVES + WAVE())
    const int G = gridDim.x, bx = blockIdx.x;
    const int NGW = G * NWAVES;
    unsigned char* ws = p.ws;
    volatile LAS unsigned* MISC = (volatile LAS unsigned*)(lds + LDS_BYTES - 64);
    unsigned* barw = (unsigned*)(ws + WS_BAR);
    if (threadIdx.x < 16) MISC[threadIdx.x] = 0u;
    if (bx == 0) for (int i = threadIdx.x; i < XCD_BAR_WORDS; i += NWAVES * 64) __hip_atomic_store(barw + i, 0u, __ATOMIC_RELAXED, __HIP_MEMORY_SCOPE_AGENT);
    __syncthreads();
    bf16* W1A = (bf16*)(ws + WS_W1A); bf16* W1D = (bf16*)(ws + WS_W1D); bf16* WIN = (bf16*)(ws + WS_WIN); bf16* WOUT = (bf16*)(ws + WS_WOUT);
    bf16* W2A = (bf16*)(ws + WS_W2A); bf16* W2D = (bf16*)(ws + WS_W2D); bf16* XN = (bf16*)(ws + WS_XN); bf16* HB = (bf16*)(ws + WS_H);
    bf16* PT = (bf16*)(ws + WS_PT); bf16* QKV = (bf16*)(ws + WS_QKV); bf16* Y = (bf16*)(ws + WS_Y);

    {
        const int lane = TID() & 63, gw = GW();
        LAS float* scr = (LAS float*)(lds + WAVE() * 16384);
        constexpr int I_UP = 16 * 88, I_DN = 44 * 32, I_IN = 16 * 96, I_OUT = 16 * 32;
        constexpr int NITEMS = 2 * (2 * I_UP + I_DN) + I_IN + I_OUT;
        for (int it = gw; it < NITEMS; it += NGW) {
            int r = it;
            if (r < I_UP) { p0_transpose_mat(p.in[I_WG1], D, FF, W1A, 1, r, scr, lane); continue; } r -= I_UP;
            if (r < I_UP) { p0_transpose_mat(p.in[I_WU1], D, FF, W1A, 2, r, scr, lane); continue; } r -= I_UP;
            if (r < I_DN) { p0_transpose_mat(p.in[I_WD1], FF, D, W1D, 0, r, scr, lane); continue; } r -= I_DN;
            if (r < I_UP) { p0_transpose_mat(p.in[I_WG2], D, FF, W2A, 1, r, scr, lane); continue; } r -= I_UP;
            if (r < I_UP) { p0_transpose_mat(p.in[I_WU2], D, FF, W2A, 2, r, scr, lane); continue; } r -= I_UP;
            if (r < I_DN) { p0_transpose_mat(p.in[I_WD2], FF, D, W2D, 0, r, scr, lane); continue; } r -= I_DN;
            if (r < I_IN) { p0_transpose_mat(p.in[I_WIN], D, 3072, WIN, 0, r, scr, lane); continue; } r -= I_IN;
            p0_transpose_mat(p.in[I_WOUT], D, D, WOUT, 0, r, scr, lane);
        }
        { const int ln = TID() & 63; for (int m = gw; m < M; m += NGW) rms_row_to_bf16(p.in[I_X] + (size_t)m * D, p.in[I_G1], XN + (size_t)m * D, ln); }
        __syncthreads();
        filt_stage1(p, lds, TID());
    }
    grid.sync();
    const XcdBarrier bar = xcd_barrier_post(barw, MISC + 8);
    filt_stage2(p, lds, TID());
    {
        pg8::Gemm g{XN, W1A, M, 2 * FF, D, nullptr, nullptr}; pg8::StaticOrder S; S.init(M, 2 * FF, G, bx);
        pg8::EpiSwiglu E{HB, FF};
        pg8::gemm_phase<pg8::EpiSwiglu, pg8::StaticOrder, true, true>(lds, g, S, E);
    }
    xcd_barrier(bar);
    {
        pg8::Gemm g{HB, W1D, M, D, FF, nullptr, nullptr}; pg8::StaticOrder S; S.init(M, D, G, bx);
        pg8::EpiResid E{p.in[I_X], p.out, D, 0.5f};
        pg8::gemm_phase<pg8::EpiResid, pg8::StaticOrder, true, true>(lds, g, S, E);
    }
    xcd_barrier(bar);
    { const int ln = TID() & 63, gw = GW(); for (int m = gw; m < M; m += NGW) rms_row_to_bf16(p.out + (size_t)m * D, p.in[I_GMIX], XN + (size_t)m * D, ln); }
    xcd_barrier(bar);
    {
        pg8::Gemm g{WIN, XN, 0, 0, D, XN, WIN + (size_t)NQKV * D}; pg8::WinOrder S; S.init(G, bx);
        pg8::EpiStore2 E{PT, M, QKV, NQKV};
        pg8::gemm_phase<pg8::EpiStore2, pg8::WinOrder, true, true>(lds, g, S, E);
    }
    xcd_barrier(bar);
    { const int td = TID(); for (int c = bx; c < DH; c += G) conv_unit_mfma(p, lds, c, td); }
    __syncthreads();
    { const int ln = TID() & 63, gw = GW(); for (int it = gw; it < 8192; it += NGW) attn_item(p, lds + WAVE() * ATT_WAVE_LDS, it, ln); }
    xcd_barrier(bar);
    { const int td = TID(); for (int u = bx; u < M / 64; u += G) mixnorm_unit(p, lds, u, td); }
    __syncthreads();
    xcd_barrier(bar);
    {
        pg8::Gemm g{Y, WOUT, M, D, D, nullptr, nullptr}; pg8::StaticOrder S; S.init(M, D, G, bx);
        pg8::EpiResid E{p.out, p.out, D, 1.0f};
        pg8::gemm_phase<pg8::EpiResid, pg8::StaticOrder, true, true>(lds, g, S, E);
    }
    xcd_barrier(bar);
    { const int ln = TID() & 63, gw = GW(); for (int m = gw; m < M; m += NGW) rms_row_to_bf16(p.out + (size_t)m * D, p.in[I_G2], XN + (size_t)m * D, ln); }
    xcd_barrier(bar);
    {
        pg8::Gemm g{XN, W2A, M, 2 * FF, D, nullptr, nullptr}; pg8::StaticOrder S; S.init(M, 2 * FF, G, bx);
        pg8::EpiSwiglu E{HB, FF};
        pg8::gemm_phase<pg8::EpiSwiglu, pg8::StaticOrder, true, true>(lds, g, S, E);
    }
    xcd_barrier(bar);
    {
        pg8::Gemm g{HB, W2D, M, D, FF, nullptr, nullptr}; pg8::StaticOrder S; S.init(M, D, G, bx);
        pg8::EpiResid E{p.out, p.out, D, 0.5f};
        pg8::gemm_phase<pg8::EpiResid, pg8::StaticOrder, true, true>(lds, g, S, E);
    }
    xcd_barrier(bar);
    { const int ln = TID() & 63, gw = GW(); for (int m = gw; m < M; m += NGW) rms_row_to_f32(p.out + (size_t)m * D, p.in[I_GFIN], p.out + (size_t)m * D, ln); }
}

extern "C" void kernel_launch(void* const* d_in, const int* in_sizes, int n_in, void* d_out, int out_size, void* d_ws, size_t ws_size, hipStream_t stream) {
    static int grid = 0;
    if (grid == 0) {
        if (n_in != 26 || in_sizes[0] != M * D || out_size != M * D || ws_size < WS_END) { fprintf(stderr, "kernel_launch: unexpected shapes (n_in %d, in0 %d, out %d, ws %zu)\n", n_in, n_in > 0 ? in_sizes[0] : -1, out_size, ws_size); grid = -1; return; }
        int dev = 0, cus = 0, per_cu = 0;
        hipGetDevice(&dev); hipDeviceGetAttribute(&cus, hipDeviceAttributeMultiprocessorCount, dev);
        if (hipFuncSetAttribute((const void*)fwd_kernel, hipFuncAttributeMaxDynamicSharedMemorySize, LDS_BYTES) != hipSuccess) { fprintf(stderr, "kernel_launch: hipFuncSetAttribute failed\n"); grid = -1; return; }
        if (hipOccupancyMaxActiveBlocksPerMultiprocessor(&per_cu, (const void*)fwd_kernel, NWAVES * 64, LDS_BYTES) != hipSuccess || per_cu < 1) { fprintf(stderr, "kernel_launch: occupancy query says %d blocks per CU\n", per_cu); (void)hipGetLastError(); grid = -1; return; }
        grid = cus;
    }
    if (grid < 0) return;
    Params prm{};
    for (int i = 0; i < 26; ++i) prm.in[i] = (const float*)d_in[i];
    prm.out = (float*)d_out; prm.ws = (unsigned char*)d_ws;
    void* args[] = {&prm};
    hipError_t e = hipLaunchCooperativeKernel((const void*)fwd_kernel, dim3(grid), dim3(NWAVES * 64), args, LDS_BYTES, stream);
    if (e != hipSuccess) fprintf(stderr, "kernel_launch: cooperative launch failed: %s (grid %d)\n", hipGetErrorString(e), grid);
}
```

```cpp
#include <hip/hip_runtime.h>
#include <hip/hip_cooperative_groups.h>
#include <cstdio>
#include <cstdint>
namespace cg = cooperative_groups;
namespace pg8 {
#define PG8_LAS __attribute__((address_space(3)))
typedef unsigned short bf16_t;
typedef short bf16x8 __attribute__((ext_vector_type(8)));
typedef float f32x4 __attribute__((ext_vector_type(4)));
typedef unsigned u32x4 __attribute__((ext_vector_type(4)));
constexpr int BM = 256, BK = 64, HALF = 128, HTB = HALF * BK * 2  , STAGE_BYTES = 8 * HTB, NXCD = 8, WGM = 8;

__host__ __device__ __forceinline__ int lds_byte(int r, int c) { const int st = (r >> 4) * 2 + (c >> 5), rr = r & 15, cc = c & 31, ob = rr * 64 + cc * 2; return st * 1024 + (ob ^ (((ob >> 9) & 1) << 5)); }
__host__ __device__ __forceinline__ void stage_rc(int b, int& R, int& C) { const int st = b / 1024, sb = b % 1024, swz = sb ^ (((sb >> 9) & 1) << 5); R = (st >> 1) * 16 + swz / 64; C = (st & 1) * 32 + (swz % 64) / 2; }
__host__ __device__ __forceinline__ int perm32(int rho) { const int n = rho >> 4, i = rho & 15; return 8 * (i >> 2) + 4 * n + (i & 3); }

struct Unit { int pm, pn, z; };
struct Gemm { const bf16_t* A; const bf16_t* Bt; int M, N, K; const bf16_t* A2; const bf16_t* Bt2; };

struct StaticOrder {
    int nM, nN, nwg, G, c;
    __host__ __device__ void init(int M, int N, int G_, int c_) { nM = M / BM; nN = N / BM; nwg = nM * nN; G = G_; c = c_; }
    __host__ __device__ bool next(int i, Unit& u) const {
        const long L = (long)i * G + c; if (L >= nwg) return false;
        int wgid = (int)L; { const int q = nwg / NXCD, r = nwg % NXCD, xcd = wgid % NXCD, off = wgid / NXCD; wgid = (xcd < r ? xcd * (q + 1) : r * (q + 1) + (xcd - r) * q) + off; }
        const int nig = WGM * nN, gid = wgid / nig, fm = gid * WGM, gsz = (nM - fm) < WGM ? (nM - fm) : WGM;
        u.pm = fm + ((wgid % nig) % gsz); u.pn = (wgid % nig) / gsz; u.z = 0; return true;
    }
    __device__ __forceinline__ void a_ready(const Unit&) const {}
    __device__ __forceinline__ void done(const Unit&) const {}
};

__device__ __forceinline__ unsigned cvt_pk_bf16(float lo, float hi) { unsigned r; asm volatile("v_cvt_pk_bf16_f32 %0, %1, %2" : "=v"(r) : "v"(lo), "v"(hi)); return r; }
typedef float f32x2 __attribute__((ext_vector_type(2)));
__device__ __forceinline__ f32x2 gelu_pk(f32x2 v) {
    const f32x2 av = __builtin_elementwise_abs(v), d = av * 0.2316418882f + 1.0f;
    f32x2 t; t.x = __builtin_amdgcn_rcpf(d.x); t.y = __builtin_amdgcn_rcpf(d.y);
    f32x2 q = t * 0.5307027145f + (-0.7265760135f); q = q * t + 0.7107068705f; q = q * t + (-0.142248368f); q = q * t + 0.127414796f; q = q * t;
    const f32x2 s = (v * v) * (-0.72134752044f);
    f32x2 e; e.x = __builtin_amdgcn_exp2f(s.x); e.y = __builtin_amdgcn_exp2f(s.y);
    const f32x2 m = v * (q * e), r = v - m;
    f32x2 o; o.x = v.x < 0.f ? m.x : r.x; o.y = v.y < 0.f ? m.y : r.y; return o;
}

typedef unsigned u32x2 __attribute__((ext_vector_type(2)));
struct EpiSwiglu {
    static constexpr bool PERM = true, AFTER_DRAIN = false;
    bf16_t* H; int ldh; const float* rowss;
    __device__ __forceinline__ void operator()(const f32x4 (&acc)[2][2][4][2], const Unit& u, int wr, int wc, int fr, int fq) const {
        const int row0 = u.pm * BM + wr * 64 + fr, col0 = u.pn * HALF + wc * 32 + 8 * fq;
#pragma unroll
        for (int ai = 0; ai < 2; ++ai)
#pragma unroll
            for (int m = 0; m < 4; ++m) { bf16_t* rowp = H + (size_t)(row0 + ai * HALF + m * 16) * ldh + col0;
                const float rs = rowss ? 1.0f / sqrtf(__hip_atomic_load(rowss + row0 + ai * HALF + m * 16, __ATOMIC_RELAXED, __HIP_MEMORY_SCOPE_AGENT) * (1.0f / 1024.0f) + 1e-6f) : 1.0f;
                float o[8];
#pragma unroll
                for (int n = 0; n < 2; ++n)
#pragma unroll
                    for (int e = 0; e < 4; ++e) { const float g = acc[ai][0][m][n][e] * rs, up = acc[ai][1][m][n][e] * rs;
                        const float sg = g * __builtin_amdgcn_rcpf(1.0f + __builtin_amdgcn_exp2f(-1.4426950408889634f * g)); o[n * 4 + e] = sg * up; }
                u32x4 w; w.x = cvt_pk_bf16(o[0], o[1]); w.y = cvt_pk_bf16(o[2], o[3]); w.z = cvt_pk_bf16(o[4], o[5]); w.w = cvt_pk_bf16(o[6], o[7]);
                *(u32x4*)rowp = w; }
    }
};
struct EpiResid {
    static constexpr bool PERM = false, AFTER_DRAIN = false;
    const float* base; float* out; int ldc; float scale;
    bf16_t* xn; const float* gain; float* rowss;
    __device__ __forceinline__ void operator()(const f32x4 (&acc)[2][2][4][2], const Unit& u, int wr, int wc, int fr, int fq) const {
        const int row0 = u.pm * BM + wr * 64 + fr, col0 = u.pn * BM + wc * 32 + 4 * fq;
        f32x4 gv[2][2];
#pragma unroll
        for (int bj = 0; bj < 2; ++bj)
#pragma unroll
            for (int n = 0; n < 2; ++n) gv[bj][n] = xn ? *(const f32x4*)(gain + col0 + bj * HALF + n * 16) : (f32x4){1.f, 1.f, 1.f, 1.f};
#pragma unroll
        for (int ai = 0; ai < 2; ++ai)
#pragma unroll
            for (int m = 0; m < 4; ++m) { const size_t off = (size_t)(row0 + ai * HALF + m * 16) * ldc + col0; float ss = 0.f;
#pragma unroll
                for (int bj = 0; bj < 2; ++bj)
#pragma unroll
                    for (int n = 0; n < 2; ++n) { const f32x4 bs = *(const f32x4*)(base + off + bj * HALF + n * 16);
                        const f32x4 o = bs + acc[ai][bj][m][n] * scale;
                        *(f32x4*)(out + off + bj * HALF + n * 16) = o;
                        ss += (o[0] * o[0] + o[1] * o[1]) + (o[2] * o[2] + o[3] * o[3]);
                        if (xn) { const f32x4 t = o * gv[bj][n]; u32x2 w; w.x = cvt_pk_bf16(t[0], t[1]); w.y = cvt_pk_bf16(t[2], t[3]); *(u32x2*)(xn + off + bj * HALF + n * 16) = w; } }
                if (rowss) { ss += __shfl_xor(ss, 16); ss += __shfl_xor(ss, 32); if (fq == 0) atomicAdd(rowss + row0 + ai * HALF + m * 16, ss); } }
    }
};
struct EpiStore2 {
    static constexpr bool PERM = true, AFTER_DRAIN = false;
    bf16_t* O0; int ld0; bf16_t* O1; int ld1; const float* tokss;
    __device__ __forceinline__ void operator()(const f32x4 (&acc)[2][2][4][2], const Unit& u, int wr, int wc, int fr, int fq) const {
        bf16_t* O = u.z ? O1 : O0; const int ldc = u.z ? ld1 : ld0;
        const int row0 = u.pm * BM + wr * 64 + fr, col0 = u.pn * BM + wc * 32 + 8 * fq;
        f32x4 cs[2][2];
        if (u.z == 0) {
#pragma unroll
            for (int bj = 0; bj < 2; ++bj)
#pragma unroll
                for (int n = 0; n < 2; ++n) { f32x4 t;
#pragma unroll
                    for (int e = 0; e < 4; ++e) t[e] = 1.0f / sqrtf(__hip_atomic_load(tokss + col0 + bj * HALF + 4 * n + e, __ATOMIC_RELAXED, __HIP_MEMORY_SCOPE_AGENT) * (1.0f / 1024.0f) + 1e-6f);
                    cs[bj][n] = t; }
        } else { cs[0][0] = cs[0][1] = cs[1][0] = cs[1][1] = (f32x4){1.f, 1.f, 1.f, 1.f}; }
#pragma unroll
        for (int ai = 0; ai < 2; ++ai)
#pragma unroll
            for (int m = 0; m < 4; ++m) { bf16_t* rowp = O + (size_t)(row0 + ai * HALF + m * 16) * ldc + col0;
                const float rs = u.z ? 1.0f / sqrtf(__hip_atomic_load(tokss + row0 + ai * HALF + m * 16, __ATOMIC_RELAXED, __HIP_MEMORY_SCOPE_AGENT) * (1.0f / 1024.0f) + 1e-6f) : 1.0f;
#pragma unroll
                for (int bj = 0; bj < 2; ++bj) { const f32x4 v0 = acc[ai][bj][m][0] * cs[bj][0] * rs, v1 = acc[ai][bj][m][1] * cs[bj][1] * rs;
                    u32x4 w; w.x = cvt_pk_bf16(v0[0], v0[1]); w.y = cvt_pk_bf16(v0[2], v0[3]); w.z = cvt_pk_bf16(v1[0], v1[1]); w.w = cvt_pk_bf16(v1[2], v1[3]);
                    *(u32x4*)(rowp + bj * HALF) = w; } }
    }
};
struct WinOrder {
    StaticOrder so;
    __host__ __device__ void init(int G_, int c_) { so.init(64 * BM, 12 * BM, G_, c_); }
    __host__ __device__ bool next(int i, Unit& u) const {
        Unit v; if (!so.next(i, v)) return false;
        if (v.pn < 6) { u.pm = v.pn; u.pn = v.pm; u.z = 0; } else { u.pm = v.pm; u.pn = v.pn - 6; u.z = 1; }
        return true;
    }
    __device__ __forceinline__ void a_ready(const Unit&) const {}
    __device__ __forceinline__ void done(const Unit&) const {}
};
template <class Epi, class Sched, bool ALIGN_EPI = false, bool SP2 = false>
__device__ __forceinline__ void gemm_phase(PG8_LAS unsigned char* lds, const Gemm g, const Sched& S, const Epi& E) {
    int tid_ = threadIdx.x; asm volatile("" : "+v"(tid_));
    const int tid = tid_, wid = __builtin_amdgcn_readfirstlane(tid >> 6), lane = tid & 63, wr = wid >> 2, wc = wid & 3, fr = lane & 15, fq = lane >> 4;
    const int K = g.K, nt = K / BK;
    unsigned voffA[2], voffB[2];
#pragma unroll
    for (int i = 0; i < 2; ++i) { int R, C; stage_rc(tid * 16 + i * 8192, R, C); const int Rb = Epi::PERM ? ((R & ~31) + perm32(R & 31)) : R;
        voffA[i] = (unsigned)(R * K + C) * 2u; voffB[i] = (unsigned)(Rb * K + C) * 2u; }
    const size_t kstep = (size_t)(BK * 2);
    const size_t hstep = (size_t)HALF * K * 2;
    const size_t tstep = 2 * hstep;
    const unsigned ldsw = (unsigned)wid * 1024u;
    const int aoff = lds_byte(wr * 64 + fr, fq * 8), boff = lds_byte(wc * 32 + fr, fq * 8);
#define PG8_SA(b, h) (((b) * 2 + (h)) * HTB)
#define PG8_SB(b, h) ((4 + (b) * 2 + (h)) * HTB)
#define PG8_STAGE(bufoff, gbase, voff) do { _Pragma("unroll") for (int _i = 0; _i < 2; ++_i) \
        __builtin_amdgcn_global_load_lds((const unsigned*)((const char*)(gbase) + (voff)[_i]), (PG8_LAS unsigned*)(lds + (bufoff) + ldsw + _i * 8192), 16, 0, 0); } while (0)
#define PG8_LDA(dst, b, h) do { _Pragma("unroll") for (int m = 0; m < 4; ++m) _Pragma("unroll") for (int k = 0; k < 2; ++k) dst[m][k] = *(const PG8_LAS bf16x8*)(lds + PG8_SA(b, h) + aoff + m * 2048 + k * 1024); } while (0)
#define PG8_LDB(dst, b, h) do { _Pragma("unroll") for (int n = 0; n < 2; ++n) _Pragma("unroll") for (int k = 0; k < 2; ++k) dst[n][k] = *(const PG8_LAS bf16x8*)(lds + PG8_SB(b, h) + boff + n * 2048 + k * 1024); } while (0)
#define PG8_MMA(ai, bj, At, Bt) do { __builtin_amdgcn_s_setprio(1); _Pragma("unroll") for (int m = 0; m < 4; ++m) _Pragma("unroll") for (int n = 0; n < 2; ++n) _Pragma("unroll") for (int k = 0; k < 2; ++k) \
        acc[ai][bj][m][n] = __builtin_amdgcn_mfma_f32_16x16x32_bf16(Bt[n][k], At[m][k], acc[ai][bj][m][n], 0, 0, 0); __builtin_amdgcn_s_setprio(0); } while (0)
#define PG8_WAIT_V(n) asm volatile("s_waitcnt vmcnt(" #n ")" ::: "memory")
#define PG8_WAIT_L(n) asm volatile("s_waitcnt lgkmcnt(" #n ")" ::: "memory")
#define PG8_BAR __builtin_amdgcn_s_barrier()
#define PG8_SCHED __builtin_amdgcn_sched_barrier(0)
    Unit cur, nxt; int ui = 0;
    if (!S.next(0, cur)) return;
    f32x4 acc[2][2][4][2];
#pragma unroll
    for (int a = 0; a < 2; ++a)
#pragma unroll
        for (int b = 0; b < 2; ++b)
#pragma unroll
            for (int m = 0; m < 4; ++m)
#pragma unroll
                for (int n = 0; n < 2; ++n) acc[a][b][m][n] = (f32x4){0.f, 0.f, 0.f, 0.f};
    bf16x8 At[4][2], B0[2][2], B1[2][2];
    const char* cA = (const char*)(cur.z ? g.A2 : g.A) + (size_t)cur.pm * tstep; const char* cB = (const char*)(cur.z ? g.Bt2 : g.Bt) + (size_t)cur.pn * tstep;
    S.a_ready(cur);
    if constexpr (SP2) {
        PG8_STAGE(PG8_SB(0, 0), cB, voffB); PG8_STAGE(PG8_SB(0, 1), cB + hstep, voffB); PG8_STAGE(PG8_SA(0, 0), cA, voffA); PG8_STAGE(PG8_SA(0, 1), cA + hstep, voffA);
        if (wr == 1) PG8_BAR;
        PG8_WAIT_V(2); PG8_BAR;
        PG8_STAGE(PG8_SB(1, 0), cB + kstep, voffB); PG8_STAGE(PG8_SA(1, 0), cA + kstep, voffA); PG8_STAGE(PG8_SB(1, 1), cB + hstep + kstep, voffB);
        PG8_WAIT_V(6); PG8_BAR;
    } else {
        PG8_STAGE(PG8_SB(0, 0), cB, voffB); PG8_STAGE(PG8_SA(0, 0), cA, voffA); PG8_STAGE(PG8_SB(0, 1), cB + hstep, voffB); PG8_STAGE(PG8_SA(0, 1), cA + hstep, voffA);
        if (wr == 1) PG8_BAR;
        PG8_WAIT_V(4); PG8_BAR;
        PG8_STAGE(PG8_SB(1, 0), cB + kstep, voffB); PG8_STAGE(PG8_SA(1, 0), cA + kstep, voffA); PG8_STAGE(PG8_SB(1, 1), cB + hstep + kstep, voffB);
        PG8_WAIT_V(6); PG8_BAR;
    }
    for (;;) {
        const bool has_next = S.next(ui + 1, nxt);
        const char* nA = has_next ? (const char*)(nxt.z ? g.A2 : g.A) + (size_t)nxt.pm * tstep : cA; const char* nB = has_next ? (const char*)(nxt.z ? g.Bt2 : g.Bt) + (size_t)nxt.pn * tstep : cB;
        for (int t = 0; t < nt; t += 2) {
            const bool last = (t == nt - 2);
            const char* a1 = cA + (size_t)(t + 1) * kstep;
            const char* a2 = last ? nA : cA + (size_t)(t + 2) * kstep; const char* b2 = last ? nB : cB + (size_t)(t + 2) * kstep;
            const char* a3 = a2 + kstep; const char* b3 = b2 + kstep;
            if (last && has_next) S.a_ready(nxt);
            if constexpr (SP2) {
            PG8_LDB(B0, 0, 0); PG8_LDB(B1, 0, 1); PG8_SCHED; PG8_LDA(At, 0, 0); PG8_STAGE(PG8_SA(1, 1), a1 + hstep, voffA);
            PG8_WAIT_V(8); PG8_WAIT_L(0); PG8_BAR; PG8_MMA(0, 0, At, B0); PG8_MMA(0, 1, At, B1); PG8_BAR; PG8_SCHED;
            PG8_LDA(At, 0, 1); PG8_STAGE(PG8_SB(0, 0), b2, voffB); PG8_STAGE(PG8_SB(0, 1), b2 + hstep, voffB); PG8_STAGE(PG8_SA(0, 0), a2, voffA);
            PG8_WAIT_V(8); PG8_WAIT_L(0); PG8_BAR; PG8_MMA(1, 0, At, B0); PG8_MMA(1, 1, At, B1); PG8_BAR; PG8_SCHED;
            PG8_LDB(B0, 1, 0); PG8_LDB(B1, 1, 1); PG8_SCHED; PG8_LDA(At, 1, 0); PG8_STAGE(PG8_SA(0, 1), a2 + hstep, voffA);
            PG8_WAIT_V(8); PG8_WAIT_L(0); PG8_BAR; PG8_MMA(0, 0, At, B0); PG8_MMA(0, 1, At, B1); PG8_BAR; PG8_SCHED;
            PG8_LDA(At, 1, 1); PG8_STAGE(PG8_SB(1, 0), b3, voffB); PG8_STAGE(PG8_SB(1, 1), b3 + hstep, voffB); PG8_STAGE(PG8_SA(1, 0), a3, voffA);
            PG8_WAIT_V(8); PG8_WAIT_L(0); PG8_BAR; PG8_MMA(1, 0, At, B0); PG8_MMA(1, 1, At, B1); PG8_BAR; PG8_SCHED;
            } else {
            PG8_LDB(B0, 0, 0); PG8_SCHED; PG8_LDA(At, 0, 0); PG8_STAGE(PG8_SA(1, 1), a1 + hstep, voffA);
            PG8_WAIT_L(8); PG8_BAR; PG8_WAIT_L(0); PG8_MMA(0, 0, At, B0); PG8_BAR; PG8_SCHED;
            PG8_LDB(B1, 0, 1); PG8_STAGE(PG8_SB(0, 0), b2, voffB);
            PG8_BAR; PG8_WAIT_L(0); PG8_MMA(0, 1, At, B1); PG8_BAR;
            PG8_LDA(At, 0, 1); PG8_STAGE(PG8_SA(0, 0), a2, voffA);
            PG8_BAR; PG8_WAIT_L(0); PG8_MMA(1, 0, At, B0); PG8_BAR; PG8_SCHED;
            PG8_STAGE(PG8_SB(0, 1), b2 + hstep, voffB);
            PG8_WAIT_V(6); PG8_BAR; PG8_MMA(1, 1, At, B1); PG8_BAR;
            PG8_LDB(B0, 1, 0); PG8_SCHED; PG8_LDA(At, 1, 0); PG8_STAGE(PG8_SA(0, 1), a2 + hstep, voffA);
            PG8_WAIT_L(8); PG8_BAR; PG8_WAIT_L(0); PG8_MMA(0, 0, At, B0); PG8_BAR; PG8_SCHED;
            PG8_LDB(B1, 1, 1); PG8_STAGE(PG8_SB(1, 0), b3, voffB);
            PG8_BAR; PG8_WAIT_L(0); PG8_MMA(0, 1, At, B1); PG8_BAR;
            PG8_LDA(At, 1, 1); PG8_STAGE(PG8_SA(1, 0), a3, voffA);
            PG8_BAR; PG8_WAIT_L(0); PG8_MMA(1, 0, At, B0); PG8_BAR; PG8_SCHED;
            PG8_STAGE(PG8_SB(1, 1), b3 + hstep, voffB);
            PG8_WAIT_V(6); PG8_BAR; PG8_MMA(1, 1, At, B1); PG8_BAR;
            }
        }
        if constexpr (ALIGN_EPI) { if (wr == 0) PG8_BAR; }
        if constexpr (!Epi::AFTER_DRAIN) { E(acc, cur, wr, wc, fr, fq); S.done(cur); }
        if (!has_next) break;
#pragma unroll
        for (int a = 0; a < 2; ++a)
#pragma unroll
            for (int b = 0; b < 2; ++b)
#pragma unroll
                for (int m = 0; m < 4; ++m)
#pragma unroll
                    for (int n = 0; n < 2; ++n) acc[a][b][m][n] = (f32x4){0.f, 0.f, 0.f, 0.f};
        cur = nxt; cA = nA; cB = nB; ++ui;
        if constexpr (ALIGN_EPI) { if (wr == 1) PG8_BAR; }
    }
    PG8_WAIT_V(0);
    if constexpr (!ALIGN_EPI) { if (wr == 0) PG8_BAR; }
    PG8_BAR;
    if constexpr (Epi::AFTER_DRAIN) { E.fused(acc, cur, wr, wc, fr, fq, lds, wid, lane); S.done(cur); }
#undef PG8_SA
#undef PG8_SB
#undef PG8_STAGE
#undef PG8_LDA
#undef PG8_LDB
#undef PG8_MMA
#undef PG8_WAIT_V
#undef PG8_WAIT_L
#undef PG8_BAR
#undef PG8_SCHED
}
}
constexpr int NWAVES = 8;
constexpr int M = 16384, D = 1024, FF = 2816, NBATCH = 8, SEQ = 2048, DH = 512, NQKV = 1536;
constexpr float RMS_EPS = 1e-6f;
constexpr int LDS_BYTES = 147456;
constexpr size_t MiB = 1u << 20;
constexpr size_t WS_W1A = 0, WS_W1D = 11 * MiB, WS_WIN = 17 * MiB, WS_WOUT = 23 * MiB, WS_W2A = 25 * MiB, WS_W2D = 36 * MiB;
constexpr size_t WS_XN = 42 * MiB;
constexpr size_t WS_H = 74 * MiB;
constexpr size_t WS_PT = 74 * MiB;
constexpr size_t WS_QKV = 122 * MiB;
constexpr size_t WS_YHT = 170 * MiB;
constexpr size_t WS_YA = 186 * MiB;
constexpr size_t WS_Y = 202 * MiB;
constexpr size_t WS_G = 234 * MiB;
constexpr size_t WS_SS = 242 * MiB;
constexpr size_t WS_BAR = 243 * MiB;
constexpr size_t WS_END = 244 * MiB;

#define LAS __attribute__((address_space(3)))
typedef unsigned short bf16;
typedef float f32x4 __attribute__((ext_vector_type(4)));
typedef unsigned u32x4 __attribute__((ext_vector_type(4)));
using pg8::u32x2;
typedef short bf16x8 __attribute__((ext_vector_type(8)));
typedef short s16x4 __attribute__((ext_vector_type(4)));
#define LDS_WAIT() asm volatile("s_waitcnt lgkmcnt(0)" ::: "memory")
using pg8::cvt_pk_bf16;
__device__ __forceinline__ float bf2f(unsigned v) { return __uint_as_float(v << 16); }
__device__ __forceinline__ unsigned f2bf(float f) { return cvt_pk_bf16(f, 0.f) & 0xffffu; }
__device__ __forceinline__ float wave_sum(float v) {
#pragma unroll
    for (int o = 1; o < 64; o <<= 1) v += __shfl_xor(v, o);
    return v;
}

struct Params { const float* in[26]; float* out; unsigned char* ws; };
enum { I_X = 0, I_G1, I_WG1, I_WU1, I_WD1, I_GMIX, I_WIN, I_CW, I_CB, I_FW1, I_FB1, I_FW2, I_FB2, I_FW3, I_FB3, I_FWO, I_FREQ, I_SKIP, I_GHY, I_GAT, I_WOUT, I_G2, I_WG2, I_WU2, I_WD2, I_GFIN };

__device__ __forceinline__ void p0_transpose_item(const float* W, int K, int N, bf16* WT, int k0, int n0, int drow0, LAS float* scr, int lane) {
    float tv[32];
    const float* wp = W + (size_t)(k0 + (lane >> 5)) * N + n0 + (lane & 31);
#pragma unroll
    for (int i = 0; i < 32; ++i) tv[i] = wp[(size_t)(2 * i) * N];
#pragma unroll
    for (int i = 0; i < 32; ++i) scr[(2 * i + (lane >> 5)) * 33 + (lane & 31)] = tv[i];
    LDS_WAIT();
    const int c = lane & 7;
#pragma unroll
    for (int j = 0; j < 4; ++j) { const int n = (lane >> 3) + 8 * j; const LAS float* s = scr + (8 * c) * 33 + n;
        u32x4 o; o.x = cvt_pk_bf16(s[0 * 33], s[1 * 33]); o.y = cvt_pk_bf16(s[2 * 33], s[3 * 33]); o.z = cvt_pk_bf16(s[4 * 33], s[5 * 33]); o.w = cvt_pk_bf16(s[6 * 33], s[7 * 33]);
        *(u32x4*)(WT + (size_t)(drow0 + n) * K + k0 + 8 * c) = o; }
    LDS_WAIT();
}
__device__ __forceinline__ void p0_transpose_mat(const float* W, int K, int N, bf16* WT, int mode, int item, LAS float* scr, int lane) {
    const int nblk = N / 32, kb = item / nblk, nb = item % nblk, n0 = 32 * nb;
    const int drow0 = mode == 0 ? n0 : (256 * (n0 / 128) + (n0 % 128) + (mode == 2 ? 128 : 0));
    p0_transpose_item(W, K, N, WT, 64 * kb, n0, drow0, scr, lane);
}
__device__ __forceinline__ void rms_row_to_bf16(const float* xrow, const float* g, bf16* orow, int lane) {
    const f32x4* xr = (const f32x4*)xrow + lane; const f32x4* gr = (const f32x4*)g + lane;
    f32x4 v[4]; float s = 0.f;
#pragma unroll
    for (int j = 0; j < 4; ++j) { v[j] = xr[64 * j]; s += (v[j].x * v[j].x + v[j].y * v[j].y) + (v[j].z * v[j].z + v[j].w * v[j].w); }
    const float rstd = 1.0f / sqrtf(wave_sum(s) * (1.f / D) + RMS_EPS);
    u32x2* o8 = (u32x2*)orow + lane;
#pragma unroll
    for (int j = 0; j < 4; ++j) { const f32x4 gv = gr[64 * j]; u32x2 w; w.x = cvt_pk_bf16(v[j].x * rstd * gv.x, v[j].y * rstd * gv.y); w.y = cvt_pk_bf16(v[j].z * rstd * gv.z, v[j].w * rstd * gv.w); o8[64 * j] = w; }
}
__device__ __forceinline__ void rms_row_to_f32_ss(const float* xrow, const float* g, float* orow, float ss, int lane) {
    const f32x4* xr = (const f32x4*)xrow + lane; const f32x4* gr = (const f32x4*)g + lane;
    const float rstd = 1.0f / sqrtf(ss * (1.f / D) + RMS_EPS);
    f32x4* o = (f32x4*)orow + lane;
#pragma unroll
    for (int j = 0; j < 4; ++j) { const f32x4 gv = gr[64 * j]; o[64 * j] = xr[64 * j] * rstd * gv; }
}
__device__ __forceinline__ void rms_row_to_f32(const float* xrow, const float* g, float* orow, int lane) {
    const f32x4* xr = (const f32x4*)xrow + lane; const f32x4* gr = (const f32x4*)g + lane;
    f32x4 v[4]; float s = 0.f;
#pragma unroll
    for (int j = 0; j < 4; ++j) { v[j] = xr[64 * j]; s += (v[j].x * v[j].x + v[j].y * v[j].y) + (v[j].z * v[j].z + v[j].w * v[j].w); }
    const float rstd = 1.0f / sqrtf(wave_sum(s) * (1.f / D) + RMS_EPS);
    f32x4* o = (f32x4*)orow + lane;
#pragma unroll
    for (int j = 0; j < 4; ++j) { const f32x4 gv = gr[64 * j]; o[64 * j] = v[j] * rstd * gv; }
}

__device__ __forceinline__ void filt_gen(const Params& p, LAS unsigned char* lds, int tid) {
    const int wave = tid >> 6, j = tid & 63;
    LAS float* zb = (LAS float*)lds + wave * 192; LAS float* ha = zb + 64; LAS float* hb = zb + 128;
    LAS float* w1l = (LAS float*)(lds + 8192); LAS float* w2l = w1l + 33 * 64; LAS float* w3l = w2l + 64 * 64; LAS float* h3l = w3l + 64 * 64;
    bf16* G = (bf16*)(p.ws + WS_G);
    for (int i = tid; i < 33 * 64; i += NWAVES * 64) w1l[i] = p.in[I_FW1][i];
    for (int i = tid; i < 64 * 64; i += NWAVES * 64) { w2l[i] = p.in[I_FW2][i]; w3l[i] = p.in[I_FW3][i]; }
    const float fq = p.in[I_FREQ][j], b1 = p.in[I_FB1][j], b2 = p.in[I_FB2][j], b3 = p.in[I_FB3][j];
    __syncthreads();
    for (int base = blockIdx.x * 8; base < SEQ; base += gridDim.x * 8) {
        const int pos = base + wave;
        const float tl = (float)pos / 2047.0f, w = (6.283185307179586f * (float)pos) / 2048.0f;
        if (j < 33) { float z; if (j == 0) z = tl; else { const int i = (j - 1) & 15; const float f = 1e-4f + (float)i * ((15.0f - 1e-4f) / 15.0f); z = (j <= 16) ? cosf(f * w) : -sinf(f * w); } zb[j] = z; }
        __syncthreads();
        { float a = b1;
#pragma unroll
          for (int i = 0; i < 33; ++i) a += zb[i] * w1l[i * 64 + j];
          ha[j] = sinf(fq * a); }
        __syncthreads();
        { float a = b2;
#pragma unroll
          for (int i = 0; i < 64; ++i) a += ha[i] * w2l[i * 64 + j];
          hb[j] = sinf(fq * a); }
        __syncthreads();
        { float a = b3;
#pragma unroll
          for (int i = 0; i < 64; ++i) a += hb[i] * w3l[i * 64 + j];
          h3l[wave * 64 + j] = sinf(fq * a); }
        __syncthreads();
        float acc[4][8];
#pragma unroll
        for (int q = 0; q < 4; ++q)
#pragma unroll
            for (int pp = 0; pp < 8; ++pp) acc[q][pp] = 0.f;
        const float* wo = p.in[I_FWO] + tid;
#pragma unroll 2
        for (int j4 = 0; j4 < 16; ++j4) {
            f32x4 hv[8];
#pragma unroll
            for (int pp = 0; pp < 8; ++pp) hv[pp] = *(const LAS f32x4*)(h3l + pp * 64 + 4 * j4);
#pragma unroll
            for (int q = 0; q < 4; ++q) { const float* wq = wo + (size_t)(4 * j4) * 2048 + 512 * q;
                const float w0 = wq[0], w1 = wq[2048], w2 = wq[4096], w3 = wq[6144];
#pragma unroll
                for (int pp = 0; pp < 8; ++pp) acc[q][pp] += (hv[pp].x * w0 + hv[pp].y * w1) + (hv[pp].z * w2 + hv[pp].w * w3); }
        }
#pragma unroll
        for (int q = 0; q < 4; ++q) { const int col = tid + 512 * q, o = col >> 10, dir = (col >> 9) & 1, c = col & 511;
            const float ad = 3.0701134573253943f + (float)c * ((15.350567286626972f - 3.0701134573253943f) / 511.0f);
            bf16* gp = G + (size_t)(c * 2 + o) * 4096;
            float v[8];
#pragma unroll
            for (int pp = 0; pp < 8; ++pp) v[pp] = acc[q][pp] * expf(-((float)(base + pp) / 2047.0f) * ad);
            if (dir == 0) { u32x4 w4; w4.x = cvt_pk_bf16(v[0], v[1]); w4.y = cvt_pk_bf16(v[2], v[3]); w4.z = cvt_pk_bf16(v[4], v[5]); w4.w = cvt_pk_bf16(v[6], v[7]); *(u32x4*)(gp + 2048 + base) = w4; }
            else {
#pragma unroll
                for (int pp = 0; pp < 8; ++pp) { if (base + pp > 0) gp[2048 - base - pp] = (bf16)f2bf(v[pp]); else gp[0] = 0; } }
        }
        __syncthreads();
    }
}

__device__ __forceinline__ float sconv(const bf16* row, int t, float w0, float w1, float w2, float bias) {
    float a = bias + w1 * bf2f(row[t]);
    if (t > 0) a += w0 * bf2f(row[t - 1]);
    if (t < SEQ - 1) a += w2 * bf2f(row[t + 1]);
    return a;
}
__device__ __forceinline__ void conv_unit_scalar(const Params& p, LAS unsigned char* lds, int c, int tid) {
    LAS float* g = (LAS float*)lds;
    LAS bf16* zA = (LAS bf16*)(lds + 16384);
    LAS bf16* zB = (LAS bf16*)(lds + 16384 + 32768);
    const bf16* PT = (const bf16*)(p.ws + WS_PT); const bf16* G = (const bf16*)(p.ws + WS_G); bf16* YHT = (bf16*)(p.ws + WS_YHT);
    const float* cw = p.in[I_CW]; const float* cb = p.in[I_CB];
    float x1c[4][8], x2c[4][8];
    {
        const float v0 = cw[c], v1 = cw[1536 + c], v2 = cw[3072 + c], vb = cb[c];
        const float a0 = cw[512 + c], a1 = cw[1536 + 512 + c], a2 = cw[3072 + 512 + c], ab = cb[512 + c];
        const float b0 = cw[1024 + c], b1 = cw[1536 + 1024 + c], b2 = cw[3072 + 1024 + c], bb = cb[1024 + c];
#pragma unroll
        for (int k = 0; k < 4; ++k)
#pragma unroll
            for (int b = 0; b < 8; ++b) { const int t = tid + 512 * k;
                zA[b * 2048 + t] = (bf16)f2bf(sconv(PT + (size_t)c * M + b * SEQ, t, v0, v1, v2, vb));
                x1c[k][b] = sconv(PT + (size_t)(512 + c) * M + b * SEQ, t, a0, a1, a2, ab);
                x2c[k][b] = sconv(PT + (size_t)(1024 + c) * M + b * SEQ, t, b0, b1, b2, bb); }
    }
    for (int o = 0; o < 2; ++o) {
        __syncthreads();
#pragma unroll
        for (int e = 0; e < 8; ++e) { const int idx = tid + 512 * e; g[idx] = bf2f(G[(size_t)(c * 2 + o) * 4096 + idx]); }
        __syncthreads();
        const LAS bf16* zin = o ? zB : zA;
        float acc[4][8];
#pragma unroll
        for (int k = 0; k < 4; ++k)
#pragma unroll
            for (int b = 0; b < 8; ++b) acc[k][b] = 0.f;
        for (int s = 0; s < SEQ; ++s) {
            float zv[8];
#pragma unroll
            for (int b = 0; b < 8; ++b) zv[b] = bf2f(zin[b * 2048 + s]);
#pragma unroll
            for (int k = 0; k < 4; ++k) { const float gv = g[2048 + tid + 512 * k - s];
#pragma unroll
                for (int b = 0; b < 8; ++b) acc[k][b] += gv * zv[b]; }
        }
        const float skip = p.in[I_SKIP][o * 512 + c];
#pragma unroll
        for (int k = 0; k < 4; ++k)
#pragma unroll
            for (int b = 0; b < 8; ++b) { const int t = tid + 512 * k; const float y = acc[k][b] + bf2f(zin[b * 2048 + t]) * skip;
                if (o == 0) zB[b * 2048 + t] = (bf16)f2bf(x1c[k][b] * y); else YHT[(size_t)c * M + b * SEQ + t] = (bf16)f2bf(x2c[k][b] * y); }
    }
    __syncthreads();
}
#define XB_TMO      128
#define XB_XCNT(j)  (256  + 64 * (j))
#define XB_XSUB(j)  (1280 + 64 * (j))
#define XB_XGEN(j)  (2304 + 64 * (j))
#define XB_TOP      3328
#define XB_TOPGEN   3392
#define XCD_BAR_WORDS 3456
#define XB_SPIN_CAP (1u << 18)

__device__ __forceinline__ unsigned xb_ld(unsigned* p)              { return __hip_atomic_load(p, __ATOMIC_RELAXED, __HIP_MEMORY_SCOPE_AGENT); }
__device__ __forceinline__ unsigned xb_add(unsigned* p, unsigned v) { return __hip_atomic_fetch_add(p, v, __ATOMIC_RELAXED, __HIP_MEMORY_SCOPE_AGENT); }
__device__ __forceinline__ unsigned xb_xcc_id() { return (unsigned)__builtin_amdgcn_s_getreg((3 << 11) | 20) & 0xFu; }
#define XB_SPIN(cond, bar) do { unsigned _sp = 0; while (cond) { __builtin_amdgcn_s_sleep(1); \
    if ((++_sp & 255u) == 0u) { if (xb_ld(&(bar)[XB_TMO])) break; if (_sp > XB_SPIN_CAP) { atomicAdd(&(bar)[XB_TMO], 1u); break; } } } } while (0)

struct XcdBarrier {
    unsigned* bar; unsigned x;
    volatile LAS unsigned* st;
};

__device__ __forceinline__ XcdBarrier xcd_barrier_post(unsigned* bar, volatile LAS unsigned* st) {
    XcdBarrier b; b.bar = bar; b.x = xb_xcc_id(); b.st = st;
    if (threadIdx.x == 0) (void)xb_add(&bar[XB_XCNT(b.x)], 1u);
    return b;
}
__device__ __forceinline__ void xcd_barrier_complete(unsigned* bar, unsigned x, unsigned& nloc, unsigned& nx) {
    const unsigned G = gridDim.x * gridDim.y * gridDim.z;
    unsigned sum, cnt, mine, sp = 0u;
    for (;;) {
        sum = 0u; cnt = 0u; mine = 0u;
#pragma unroll
        for (unsigned j = 0; j < 16; ++j) { const unsigned c = xb_ld(&bar[XB_XCNT(j)]); sum += c; cnt += (c > 0u) ? 1u : 0u; mine = (j == x) ? c : mine; }
        if (sum == G) break;
        __builtin_amdgcn_s_sleep(1);
        if ((++sp & 255u) == 0u) { if (xb_ld(&bar[XB_TMO])) break; if (sp > XB_SPIN_CAP) { atomicAdd(&bar[XB_TMO], 1u); break; } }
    }
    nloc = mine > 0u ? mine : 1u; nx = cnt > 0u ? cnt : 1u;
}

__device__ __forceinline__ void xcd_barrier(const XcdBarrier& b) {
    asm volatile("s_waitcnt vmcnt(0)" ::: "memory");
    __syncthreads();
    if (threadIdx.x == 0) {
        unsigned* bar = b.bar;
        __builtin_amdgcn_s_waitcnt(0);
        unsigned nloc = b.st[0], nx = b.st[1];
        if (nloc == 0u) { xcd_barrier_complete(bar, b.x, nloc, nx); b.st[0] = nloc; b.st[1] = nx; }
        const unsigned old = xb_add(&bar[XB_XSUB(b.x)], 1u);
        const unsigned gen = old / nloc;
        if (old + 1u == (gen + 1u) * nloc) {
            __builtin_amdgcn_fence(__ATOMIC_RELEASE, "agent");
            asm volatile("s_waitcnt vmcnt(0)" ::: "memory");
            const unsigned og = xb_add(&bar[XB_TOP], 1u);
            const unsigned tg = og / nx;
            if (og + 1u == (tg + 1u) * nx) xb_add(&bar[XB_TOPGEN], 1u);
            else XB_SPIN(xb_ld(&bar[XB_TOPGEN]) == tg, bar);
            __builtin_amdgcn_fence(__ATOMIC_ACQUIRE, "agent");
            xb_add(&bar[XB_XGEN(b.x)], 1u);
            asm volatile("s_waitcnt vmcnt(0)" ::: "memory");
        } else {
            XB_SPIN(xb_ld(&bar[XB_XGEN(b.x)]) == gen, bar);
            __builtin_amdgcn_fence(__ATOMIC_ACQUIRE, "agent");
            asm volatile("s_waitcnt vmcnt(0)" ::: "memory");
        }
    }
    __syncthreads();
}
constexpr int CV_GCS = 8224, CV_ZBLK = 79, CV_ZA = 8 * CV_GCS, CV_ZB = CV_ZA + CV_ZBLK * 512;
static_assert(CV_ZB + CV_ZBLK * 512 <= LDS_BYTES - 64, "conv LDS map");
__device__ __forceinline__ void conv_build_gc(LAS unsigned char* lds, int tid, const u32x4 lo, const u32x4 hi) {
    const unsigned d[8] = {lo.x, lo.y, lo.z, lo.w, hi.x, hi.y, hi.z, hi.w};
#pragma unroll
    for (int s = 0; s < 8; ++s) {
        unsigned w[4];
#pragma unroll
        for (int j = 0; j < 4; ++j) { const int x = 8 + s - 2 * j, m = x >> 1;
            if (x & 1) w[j] = __builtin_amdgcn_alignbit(d[m], d[m], 16);
            else w[j] = (d[m] & 0xffffu) | (d[m - 1] & 0xffff0000u); }
        *(LAS u32x4*)(lds + s * CV_GCS + tid * 16) = (u32x4){w[0], w[1], w[2], w[3]};
    }
}
__device__ __forceinline__ void conv_mma(LAS unsigned char* lds, int zoff, int wave, int lane, f32x4 (&acc)[4][2]) {
    const int fr = lane & 15, fq = lane >> 4;
    const int Dlo = 8 * wave - 63, Dhi = 8 * wave + 7;
    const LAS unsigned char* ap = lds + (fr & 7) * CV_GCS + (8 * fq - 8 * (fr >> 3) + 2048) * 2 - 64 * Dlo;
    const LAS unsigned char* zp = lds + zoff + ((fr >> 3) + 7 + 8 * wave - Dlo) * 512 + (fr & 7) * 64 + fq * 16;
#pragma unroll
    for (int jt = 0; jt < 4; ++jt) { acc[jt][0] = (f32x4){0.f, 0.f, 0.f, 0.f}; acc[jt][1] = (f32x4){0.f, 0.f, 0.f, 0.f}; }
    bf16x8 a0 = *(const LAS bf16x8*)ap, a1 = *(const LAS bf16x8*)(ap - 32), bv[4];
#pragma unroll
    for (int jt = 0; jt < 4; ++jt) bv[jt] = *(const LAS bf16x8*)(zp + 1024 * jt);
#pragma unroll 2
    for (int i = 0; i <= Dhi - Dlo; ++i) {
        const int in = i < Dhi - Dlo ? i + 1 : i;
        const bf16x8 na0 = *(const LAS bf16x8*)(ap - 64 * in), na1 = *(const LAS bf16x8*)(ap - 64 * in - 32);
        bf16x8 nb[4];
#pragma unroll
        for (int jt = 0; jt < 4; ++jt) nb[jt] = *(const LAS bf16x8*)(zp + 1024 * jt - 512 * in);
#pragma unroll
        for (int jt = 0; jt < 4; ++jt) {
            acc[jt][0] = __builtin_amdgcn_mfma_f32_16x16x32_bf16(a0, bv[jt], acc[jt][0], 0, 0, 0);
            acc[jt][1] = __builtin_amdgcn_mfma_f32_16x16x32_bf16(a1, bv[jt], acc[jt][1], 0, 0, 0); }
        a0 = na0; a1 = na1;
#pragma unroll
        for (int jt = 0; jt < 4; ++jt) bv[jt] = nb[jt];
    }
}
__device__ __forceinline__ f32x4 sconv4(const bf16* row, int t0, float w0, float w1, float w2, float bias) {
    const u32x2 v = *(const u32x2*)(row + t0);
    const float c0 = bf2f(v.x & 0xffffu), c1 = bf2f(v.x >> 16), c2 = bf2f(v.y & 0xffffu), c3 = bf2f(v.y >> 16);
    const float pm = t0 > 0 ? bf2f(row[t0 - 1]) : 0.f, pp = t0 + 4 < SEQ ? bf2f(row[t0 + 4]) : 0.f;
    f32x4 o; o.x = bias + w0 * pm + w1 * c0 + w2 * c1; o.y = bias + w0 * c0 + w1 * c1 + w2 * c2; o.z = bias + w0 * c1 + w1 * c2 + w2 * c3; o.w = bias + w0 * c2 + w1 * c3 + w2 * pp;
    return o;
}
__device__ __forceinline__ void conv_unit_mfma(const Params& p, LAS unsigned char* lds, int c, int tid) {
    const int lane = tid & 63, wave = __builtin_amdgcn_readfirstlane(tid >> 6), fr = lane & 15, fq = lane >> 4, nb = fr >> 3, b = fr & 7;
    const bf16* PT = (const bf16*)(p.ws + WS_PT); const bf16* G = (const bf16*)(p.ws + WS_G); bf16* YHT = (bf16*)(p.ws + WS_YHT);
    const float* cw = p.in[I_CW]; const float* cb = p.in[I_CB];
    u32x4 glo[2], ghi[2];
#pragma unroll
    for (int o = 0; o < 2; ++o) { const bf16* gp = G + (size_t)(c * 2 + o) * 4096 + 4088 - 8 * tid; glo[o] = *(const u32x4*)gp;
        if (tid > 0) ghi[o] = *(const u32x4*)(gp + 8); else { unsigned zz; asm volatile("v_mov_b32 %0, 0" : "=v"(zz)); ghi[o] = (u32x4){zz, zz, zz, zz}; } }
    __syncthreads();
    { unsigned zz; asm volatile("v_mov_b32 %0, 0" : "=v"(zz));
#pragma unroll
        for (int k = 0; k < 2; ++k) { const int q = tid + 512 * k; if (q < 960) { const int z = q >= 480, r = q - 480 * z;
            *(LAS u32x4*)(lds + (z ? CV_ZB : CV_ZA) + (r < 224 ? r * 16 : 71 * 512 + (r - 224) * 16)) = (u32x4){zz, zz, zz, zz}; } } }
    f32x4 x1c[4][2], x2c[4][2];
    {
        const float v0 = cw[c], v1 = cw[1536 + c], v2 = cw[3072 + c], vb = cb[c];
        const float a0 = cw[512 + c], a1 = cw[1536 + 512 + c], a2 = cw[3072 + 512 + c], ab = cb[512 + c];
        const float b0 = cw[1024 + c], b1 = cw[1536 + 1024 + c], b2 = cw[3072 + 1024 + c], bb = cb[1024 + c];
#pragma unroll
        for (int jt = 0; jt < 4; ++jt)
#pragma unroll
            for (int h = 0; h < 2; ++h) { const int P = 8 * wave + 2 * jt + nb, t0 = 32 * P + 16 * h + 4 * fq;
                const f32x4 v = sconv4(PT + (size_t)c * M + b * SEQ, t0, v0, v1, v2, vb);
                u32x2 w; w.x = cvt_pk_bf16(v.x, v.y); w.y = cvt_pk_bf16(v.z, v.w);
                *(LAS u32x2*)(lds + CV_ZA + (P + 7) * 512 + b * 64 + (16 * h + 4 * fq) * 2) = w;
                x1c[jt][h] = sconv4(PT + (size_t)(512 + c) * M + b * SEQ, t0, a0, a1, a2, ab);
                x2c[jt][h] = sconv4(PT + (size_t)(1024 + c) * M + b * SEQ, t0, b0, b1, b2, bb); }
    }
#pragma unroll
    for (int o = 0; o < 2; ++o) {
        if (o == 1) __syncthreads();
        conv_build_gc(lds, tid, glo[o], ghi[o]);
        __syncthreads();
        f32x4 acc[4][2];
        const int zoff = o ? CV_ZB : CV_ZA;
        conv_mma(lds, zoff, wave, lane, acc);
        const float skip = p.in[I_SKIP][o * 512 + c];
#pragma unroll
        for (int jt = 0; jt < 4; ++jt)
#pragma unroll
            for (int h = 0; h < 2; ++h) { const int P = 8 * wave + 2 * jt + nb, t0 = 32 * P + 16 * h + 4 * fq;
                const u32x2 zi = *(const LAS u32x2*)(lds + zoff + (P + 7) * 512 + b * 64 + (16 * h + 4 * fq) * 2);
                f32x4 y; y.x = acc[jt][h].x + bf2f(zi.x & 0xffffu) * skip; y.y = acc[jt][h].y + bf2f(zi.x >> 16) * skip; y.z = acc[jt][h].z + bf2f(zi.y & 0xffffu) * skip; y.w = acc[jt][h].w + bf2f(zi.y >> 16) * skip;
                const f32x4 gate = o ? x2c[jt][h] : x1c[jt][h]; y = y * gate;
                u32x2 w; w.x = cvt_pk_bf16(y.x, y.y); w.y = cvt_pk_bf16(y.z, y.w);
                if (o == 0) *(LAS u32x2*)(lds + CV_ZB + (P + 7) * 512 + b * 64 + (16 * h + 4 * fq) * 2) = w;
                else *(u32x2*)(YHT + (size_t)c * M + b * SEQ + t0) = w; }
    }
}
typedef short v4i16_t __attribute__((ext_vector_type(4)));
__device__ __forceinline__ s16x4 vtr(const LAS unsigned char* p) { return __builtin_bit_cast(s16x4, __builtin_amdgcn_ds_read_tr16_b64_v4i16((LAS v4i16_t*)p)); }
constexpr int ATT_VROW = 144;
constexpr int ATT_WAVE_LDS = 32 * ATT_VROW;
constexpr int ATT_NPAIR = 23;
__device__ __forceinline__ void att_pair_params(int pi, int tq0, int& st, int& kb) {
    if (pi < 5) { st = 16; kb = tq0 - 1024 + 512 * pi; }
    else if (pi < 11) { st = 4; kb = tq0 - 256 + 128 * (pi - 5); }
    else { st = 1; kb = tq0 - 64 + 32 * (pi - 11); }
}
__device__ __forceinline__ void att_load(const bf16* QKVb, int h, int st, int kb, int lane, bf16x8 (&kf)[2][2], u32x4 (&vv)[4]) {
    const int fr = lane & 15, fq = lane >> 4;
#pragma unroll
    for (int ab = 0; ab < 2; ++ab) { int tk = kb + st * (16 * ab + fr); tk = tk < 0 ? 0 : (tk > SEQ - 1 ? SEQ - 1 : tk);
        const bf16* kp = QKVb + (size_t)tk * NQKV + 512 + h * 64 + 8 * fq;
        kf[ab][0] = *(const bf16x8*)kp; kf[ab][1] = *(const bf16x8*)(kp + 32); }
#pragma unroll
    for (int e = 0; e < 4; ++e) { int tk = kb + st * (8 * e + (lane >> 3)); tk = tk < 0 ? 0 : (tk > SEQ - 1 ? SEQ - 1 : tk);
        vv[e] = *(const u32x4*)(QKVb + (size_t)tk * NQKV + 1024 + h * 64 + (lane & 7) * 8); }
}
struct AttState { float m, lpart; f32x4 oacc[4]; };
__device__ __forceinline__ void att_compute(AttState& S, LAS unsigned char* vl, int st, int kb, int tq, int lane, float slope2, const bf16x8 (&qf)[2], const bf16x8 (&kf)[2][2], const u32x4 (&vv)[4]) {
    const int fr = lane & 15, fq = lane >> 4;
    const float LOG2E = 1.4426950408889634f, NEG = -1e30f, sc2 = 0.125f * LOG2E;
    f32x4 s[2];
#pragma unroll
    for (int ab = 0; ab < 2; ++ab) { s[ab] = (f32x4){0.f, 0.f, 0.f, 0.f};
        s[ab] = __builtin_amdgcn_mfma_f32_16x16x32_bf16(kf[ab][0], qf[0], s[ab], 0, 0, 0);
        s[ab] = __builtin_amdgcn_mfma_f32_16x16x32_bf16(kf[ab][1], qf[1], s[ab], 0, 0, 0); }
#pragma unroll
    for (int e = 0; e < 4; ++e) *(LAS u32x4*)(vl + (8 * e + (lane >> 3)) * ATT_VROW + (lane & 7) * 16) = vv[e];
    float sv[8]; float mx = NEG;
#pragma unroll
    for (int ab = 0; ab < 2; ++ab)
#pragma unroll
        for (int r = 0; r < 4; ++r) { const int tk = kb + st * (16 * ab + 4 * fq + r); const int dl = tk - tq, adl = dl < 0 ? -dl : dl;
            const bool valid = ((unsigned)tk < (unsigned)SEQ) && (adl <= 64 * st);
            const float x = s[ab][r] * sc2 - slope2 * (float)adl; sv[ab * 4 + r] = valid ? x : NEG; mx = fmaxf(mx, sv[ab * 4 + r]); }
    mx = fmaxf(mx, __shfl_xor(mx, 16)); mx = fmaxf(mx, __shfl_xor(mx, 32));
    const float mnew = fmaxf(S.m, mx), alpha = __builtin_amdgcn_exp2f(S.m - mnew); S.m = mnew;
    float pv[8], ps = 0.f;
#pragma unroll
    for (int i = 0; i < 8; ++i) { pv[i] = sv[i] > -1e29f ? __builtin_amdgcn_exp2f(sv[i] - mnew) : 0.f; ps += pv[i]; }
    S.lpart = S.lpart * alpha + ps;
#pragma unroll
    for (int mt = 0; mt < 4; ++mt) S.oacc[mt] = S.oacc[mt] * alpha;
    u32x4 pw; pw.x = cvt_pk_bf16(pv[0], pv[1]); pw.y = cvt_pk_bf16(pv[2], pv[3]); pw.z = cvt_pk_bf16(pv[4], pv[5]); pw.w = cvt_pk_bf16(pv[6], pv[7]);
    const bf16x8 pb = __builtin_bit_cast(bf16x8, pw);
    LDS_WAIT();
    const LAS unsigned char* va = vl + (4 * fq + (fr >> 2)) * ATT_VROW + (fr & 3) * 8;
#pragma unroll
    for (int mt = 0; mt < 4; ++mt) { const s16x4 lo = vtr(va + mt * 32), hi = vtr(va + 16 * ATT_VROW + mt * 32);
        const bf16x8 vf = (bf16x8){lo[0], lo[1], lo[2], lo[3], hi[0], hi[1], hi[2], hi[3]};
        S.oacc[mt] = __builtin_amdgcn_mfma_f32_16x16x32_bf16(vf, pb, S.oacc[mt], 0, 0, 0); }
    LDS_WAIT();
}
__device__ __forceinline__ void attn_item(const Params& p, LAS unsigned char* vl, int item, int lane) {
    const int rcls = item & 15, stile = (item >> 4) & 7, h = (item >> 7) & 7, b = item >> 10;
    const int fr = lane & 15, fq = lane >> 4;
    const bf16* QKVb = (const bf16*)(p.ws + WS_QKV) + (size_t)b * SEQ * NQKV;
    const int tq0 = 256 * stile + rcls, tq = tq0 + 16 * fr;
    bf16x8 qf[2];
    { const bf16* qp = QKVb + (size_t)tq * NQKV + h * 64 + 8 * fq; qf[0] = *(const bf16x8*)qp; qf[1] = *(const bf16x8*)(qp + 32); }
    const float slope2 = __builtin_amdgcn_exp2f(-(float)(h + 1)) * 1.4426950408889634f;
    AttState S; S.m = -1e30f; S.lpart = 0.f;
#pragma unroll
    for (int mt = 0; mt < 4; ++mt) S.oacc[mt] = (f32x4){0.f, 0.f, 0.f, 0.f};
    bf16x8 k0[2][2], k1[2][2], k2[2][2]; u32x4 v0[4], v1[4], v2[4];
    int st, kb;
#define ATT_LOAD(pi, kf, vv) do { att_pair_params((pi), tq0, st, kb); att_load(QKVb, h, st, kb, lane, kf, vv); } while (0)
#define ATT_COMP(pi, kf, vv) do { att_pair_params((pi), tq0, st, kb); att_compute(S, vl, st, kb, tq, lane, slope2, qf, kf, vv); } while (0)
    ATT_LOAD(0, k0, v0); ATT_LOAD(1, k1, v1);
    for (int pi = 0; pi < 21; pi += 3) {
        ATT_LOAD(pi + 2, k2, v2); ATT_COMP(pi, k0, v0);
        ATT_LOAD(pi + 3, k0, v0); ATT_COMP(pi + 1, k1, v1);
        ATT_LOAD(pi + 4, k1, v1); ATT_COMP(pi + 2, k2, v2);
    }
    ATT_COMP(21, k0, v0); ATT_COMP(22, k1, v1);
#undef ATT_LOAD
#undef ATT_COMP
    float l = S.lpart; l += __shfl_xor(l, 16); l += __shfl_xor(l, 32);
    const float inv = 1.0f / l;
    bf16* yp = (bf16*)(p.ws + WS_YA) + (size_t)(b * SEQ + tq) * DH + h * 64 + 4 * fq;
#pragma unroll
    for (int mt = 0; mt < 4; ++mt) { u32x2 w; w.x = cvt_pk_bf16(S.oacc[mt][0] * inv, S.oacc[mt][1] * inv); w.y = cvt_pk_bf16(S.oacc[mt][2] * inv, S.oacc[mt][3] * inv); *(u32x2*)(yp + 16 * mt) = w; }
}

__device__ __forceinline__ void mixnorm_unit(const Params& p, LAS unsigned char* lds, int unit, int tid) {
    constexpr int RS = 136;
    const int m0 = unit * 64, lane = tid & 63, wave = tid >> 6;
    const bf16* YHT = (const bf16*)(p.ws + WS_YHT); const bf16* YA = (const bf16*)(p.ws + WS_YA); bf16* Y = (bf16*)(p.ws + WS_Y);
    __syncthreads();
    { const u32x4* src = (const u32x4*)(YHT + (size_t)tid * M + m0);
#pragma unroll
        for (int q = 0; q < 8; ++q) { const u32x4 v = src[q]; LAS unsigned* d = (LAS unsigned*)(lds + tid * RS + q * 16); d[0] = v.x; d[1] = v.y; d[2] = v.z; d[3] = v.w; } }
    __syncthreads();
    const float* ghy = p.in[I_GHY]; const float* gat = p.in[I_GAT];
    for (int k = 0; k < 8; ++k) {
        const int tok = 8 * wave + k, mrow = m0 + tok;
        float v[8]; float s = 0.f;
#pragma unroll
        for (int q = 0; q < 4; ++q) { const int c = 2 * lane + 128 * q;
            v[2 * q] = bf2f(*(const LAS bf16*)(lds + c * RS + tok * 2)); v[2 * q + 1] = bf2f(*(const LAS bf16*)(lds + (c + 1) * RS + tok * 2));
            s += v[2 * q] * v[2 * q] + v[2 * q + 1] * v[2 * q + 1]; }
        const float rstd = 1.0f / sqrtf(wave_sum(s) * (1.f / DH) + RMS_EPS);
#pragma unroll
        for (int q = 0; q < 4; ++q) { const int c = 2 * lane + 128 * q;
            *(unsigned*)(Y + (size_t)mrow * D + c) = cvt_pk_bf16(v[2 * q] * rstd * ghy[c], v[2 * q + 1] * rstd * ghy[c + 1]); }
        const u32x4 a = *(const u32x4*)(YA + (size_t)mrow * DH + 8 * lane);
        float w[8]; w[0] = bf2f(a.x & 0xffffu); w[1] = bf2f(a.x >> 16); w[2] = bf2f(a.y & 0xffffu); w[3] = bf2f(a.y >> 16); w[4] = bf2f(a.z & 0xffffu); w[5] = bf2f(a.z >> 16); w[6] = bf2f(a.w & 0xffffu); w[7] = bf2f(a.w >> 16);
        float s2 = 0.f;
#pragma unroll
        for (int e = 0; e < 8; ++e) s2 += w[e] * w[e];
        const float rstd2 = 1.0f / sqrtf(wave_sum(s2) * (1.f / DH) + RMS_EPS);
        const f32x4 g0 = *(const f32x4*)(gat + 8 * lane), g1 = *(const f32x4*)(gat + 8 * lane + 4);
        u32x4 o; o.x = cvt_pk_bf16(w[0] * rstd2 * g0.x, w[1] * rstd2 * g0.y); o.y = cvt_pk_bf16(w[2] * rstd2 * g0.z, w[3] * rstd2 * g0.w);
        o.z = cvt_pk_bf16(w[4] * rstd2 * g1.x, w[5] * rstd2 * g1.y); o.w = cvt_pk_bf16(w[6] * rstd2 * g1.z, w[7] * rstd2 * g1.w);
        *(u32x4*)(Y + (size_t)mrow * D + DH + 8 * lane) = o;
    }
}

__device__ __forceinline__ int launder(int v) { asm volatile("" : "+v"(v)); return v; }
__global__ void __launch_bounds__(NWAVES * 64, 2) fwd_kernel(Params p) {
    extern __shared__ __attribute__((aligned(16))) unsigned char lds_raw[];
    LAS unsigned char* lds = (LAS unsigned char*)lds_raw;
    cg::grid_group grid = cg::this_grid();
#define TID() launder((int)threadIdx.x)
#define WAVE() __builtin_amdgcn_readfirstlane((int)(threadIdx.x >> 6))
#define GW() (bx * NWAVES + WAVE())
    const int G = gridDim.x, bx = blockIdx.x;
    const int NGW = G * NWAVES;
    unsigned char* ws = p.ws;
    volatile LAS unsigned* MISC = (volatile LAS unsigned*)(lds + LDS_BYTES - 64);
    unsigned* barw = (unsigned*)(ws + WS_BAR);
    if (threadIdx.x < 16) MISC[threadIdx.x] = 0u;
    if (bx == 0) for (int i = threadIdx.x; i < XCD_BAR_WORDS; i += NWAVES * 64) __hip_atomic_store(barw + i, 0u, __ATOMIC_RELAXED, __HIP_MEMORY_SCOPE_AGENT);
    __syncthreads();
    bf16* W1A = (bf16*)(ws + WS_W1A); bf16* W1D = (bf16*)(ws + WS_W1D); bf16* WIN = (bf16*)(ws + WS_WIN); bf16* WOUT = (bf16*)(ws + WS_WOUT);
    bf16* W2A = (bf16*)(ws + WS_W2A); bf16* W2D = (bf16*)(ws + WS_W2D); bf16* XN = (bf16*)(ws + WS_XN); bf16* HB = (bf16*)(ws + WS_H);
    float* SS = (float*)(ws + WS_SS);
    bf16* PT = (bf16*)(ws + WS_PT); bf16* QKV = (bf16*)(ws + WS_QKV); bf16* Y = (bf16*)(ws + WS_Y);

    {
        const int lane = TID() & 63, gw = GW();
        LAS float* scr = (LAS float*)(lds + WAVE() * 16384);
        constexpr int I_UP = 16 * 88, I_DN = 44 * 32, I_IN = 16 * 96, I_OUT = 16 * 32;
        constexpr int NITEMS = 2 * (2 * I_UP + I_DN) + I_IN + I_OUT;
        for (int it = gw; it < NITEMS; it += NGW) {
            int r = it;
            if (r < I_UP) { p0_transpose_mat(p.in[I_WG1], D, FF, W1A, 1, r, scr, lane); continue; } r -= I_UP;
            if (r < I_UP) { p0_transpose_mat(p.in[I_WU1], D, FF, W1A, 2, r, scr, lane); continue; } r -= I_UP;
            if (r < I_DN) { p0_transpose_mat(p.in[I_WD1], FF, D, W1D, 0, r, scr, lane); continue; } r -= I_DN;
            if (r < I_UP) { p0_transpose_mat(p.in[I_WG2], D, FF, W2A, 1, r, scr, lane); continue; } r -= I_UP;
            if (r < I_UP) { p0_transpose_mat(p.in[I_WU2], D, FF, W2A, 2, r, scr, lane); continue; } r -= I_UP;
            if (r < I_DN) { p0_transpose_mat(p.in[I_WD2], FF, D, W2D, 0, r, scr, lane); continue; } r -= I_DN;
            if (r < I_IN) { p0_transpose_mat(p.in[I_WIN], D, 3072, WIN, 0, r, scr, lane); continue; } r -= I_IN;
            p0_transpose_mat(p.in[I_WOUT], D, D, WOUT, 0, r, scr, lane);
        }
        { const int ln = TID() & 63; for (int m = gw; m < M; m += NGW) rms_row_to_bf16(p.in[I_X] + (size_t)m * D, p.in[I_G1], XN + (size_t)m * D, ln); }
        { float* ss = (float*)(ws + WS_SS); for (int i = bx * NWAVES * 64 + (int)threadIdx.x; i < 3 * M; i += G * NWAVES * 64) ss[i] = 0.f; }
        __syncthreads();
        filt_gen(p, lds, TID());
    }
    grid.sync();
    const XcdBarrier bar = xcd_barrier_post(barw, MISC + 8);
    {
        pg8::Gemm g{XN, W1A, M, 2 * FF, D, nullptr, nullptr}; pg8::StaticOrder S; S.init(M, 2 * FF, G, bx);
        pg8::EpiSwiglu E{HB, FF, nullptr};
        pg8::gemm_phase<pg8::EpiSwiglu, pg8::StaticOrder, true, true>(lds, g, S, E);
    }
    xcd_barrier(bar);
    {
        pg8::Gemm g{HB, W1D, M, D, FF, nullptr, nullptr}; pg8::StaticOrder S; S.init(M, D, G, bx);
        pg8::EpiResid E{p.in[I_X], p.out, D, 0.5f, XN, p.in[I_GMIX], SS};
        pg8::gemm_phase<pg8::EpiResid, pg8::StaticOrder, true, true>(lds, g, S, E);
    }
    xcd_barrier(bar);
    {
        pg8::Gemm g{WIN, XN, 0, 0, D, XN, WIN + (size_t)NQKV * D}; pg8::WinOrder S; S.init(G, bx);
        pg8::EpiStore2 E{PT, M, QKV, NQKV, SS};
        pg8::gemm_phase<pg8::EpiStore2, pg8::WinOrder, true, true>(lds, g, S, E);
    }
    xcd_barrier(bar);
    { const int td = TID(); for (int c = bx; c < DH; c += G) conv_unit_mfma(p, lds, c, td); }
    __syncthreads();
    { const int ln = TID() & 63, vb = (G % 8 == 0) ? (bx % 8) * (G / 8) + bx / 8 : bx, gwv = vb * NWAVES + WAVE();
      for (int it = gwv; it < 8192; it += NGW) attn_item(p, lds + WAVE() * ATT_WAVE_LDS, it, ln); }
    xcd_barrier(bar);
    { const int td = TID(); for (int u = bx; u < M / 64; u += G) mixnorm_unit(p, lds, u, td); }
    __syncthreads();
    xcd_barrier(bar);
    {
        pg8::Gemm g{Y, WOUT, M, D, D, nullptr, nullptr}; pg8::StaticOrder S; S.init(M, D, G, bx);
        pg8::EpiResid E{p.out, p.out, D, 1.0f, XN, p.in[I_G2], SS + M};
        pg8::gemm_phase<pg8::EpiResid, pg8::StaticOrder, true, true>(lds, g, S, E);
    }
    xcd_barrier(bar);
    {
        pg8::Gemm g{XN, W2A, M, 2 * FF, D, nullptr, nullptr}; pg8::StaticOrder S; S.init(M, 2 * FF, G, bx);
        pg8::EpiSwiglu E{HB, FF, SS + M};
        pg8::gemm_phase<pg8::EpiSwiglu, pg8::StaticOrder, true, true>(lds, g, S, E);
    }
    xcd_barrier(bar);
    {
        pg8::Gemm g{HB, W2D, M, D, FF, nullptr, nullptr}; pg8::StaticOrder S; S.init(M, D, G, bx);
        pg8::EpiResid E{p.out, p.out, D, 0.5f, nullptr, nullptr, SS + 2 * M};
        pg8::gemm_phase<pg8::EpiResid, pg8::StaticOrder, true, true>(lds, g, S, E);
    }
    xcd_barrier(bar);
    { const int ln = TID() & 63, gw = GW(); for (int m = gw; m < M; m += NGW) rms_row_to_f32_ss(p.out + (size_t)m * D, p.in[I_GFIN], p.out + (size_t)m * D, __hip_atomic_load(SS + 2 * M + m, __ATOMIC_RELAXED, __HIP_MEMORY_SCOPE_AGENT), ln); }
}

extern "C" void kernel_launch(void* const* d_in, const int* in_sizes, int n_in, void* d_out, int out_size, void* d_ws, size_t ws_size, hipStream_t stream) {
    static int grid = 0;
    if (grid == 0) {
        if (n_in != 26 || in_sizes[0] != M * D || out_size != M * D || ws_size < WS_END) { fprintf(stderr, "kernel_launch: unexpected shapes (n_in %d, in0 %d, out %d, ws %zu)\n", n_in, n_in > 0 ? in_sizes[0] : -1, out_size, ws_size); grid = -1; return; }
        int dev = 0, cus = 0, per_cu = 0;
        hipGetDevice(&dev); hipDeviceGetAttribute(&cus, hipDeviceAttributeMultiprocessorCount, dev);
        if (hipFuncSetAttribute((const void*)fwd_kernel, hipFuncAttributeMaxDynamicSharedMemorySize, LDS_BYTES) != hipSuccess) { fprintf(stderr, "kernel_launch: hipFuncSetAttribute failed\n"); grid = -1; return; }
        if (hipOccupancyMaxActiveBlocksPerMultiprocessor(&per_cu, (const void*)fwd_kernel, NWAVES * 64, LDS_BYTES) != hipSuccess || per_cu < 1) { fprintf(stderr, "kernel_launch: occupancy query says %d blocks per CU\n", per_cu); (void)hipGetLastError(); grid = -1; return; }
        grid = cus;
    }
    if (grid < 0) return;
    Params prm{};
    for (int i = 0; i < 26; ++i) prm.in[i] = (const float*)d_in[i];
    prm.out = (float*)d_out; prm.ws = (unsigned char*)d_ws;
    void* args[] = {&prm};
    hipError_t e = hipLaunchCooperativeKernel((const void*)fwd_kernel, dim3(grid), dim3(NWAVES * 64), args, LDS_BYTES, stream);
    if (e != hipSuccess) fprintf(stderr, "kernel_launch: cooperative launch failed: %s (grid %d)\n", hipGetErrorString(e), grid);
}
```

```cpp
#include <hip/hip_runtime.h>
#include <hip/hip_cooperative_groups.h>
#include <cstdio>
#include <cstdint>
namespace cg = cooperative_groups;
namespace pg8 {
#define PG8_LAS __attribute__((address_space(3)))
typedef unsigned short bf16_t;
typedef short bf16x8 __attribute__((ext_vector_type(8)));
typedef float f32x4 __attribute__((ext_vector_type(4)));
typedef unsigned u32x4 __attribute__((ext_vector_type(4)));
constexpr int BM = 256, BK = 64, HALF = 128, HTB = HALF * BK * 2  , STAGE_BYTES = 8 * HTB, NXCD = 8, WGM = 8;

__host__ __device__ __forceinline__ int lds_byte(int r, int c) { const int st = (r >> 4) * 2 + (c >> 5), rr = r & 15, cc = c & 31, ob = rr * 64 + cc * 2; return st * 1024 + (ob ^ (((ob >> 9) & 1) << 5)); }
__host__ __device__ __forceinline__ void stage_rc(int b, int& R, int& C) { const int st = b / 1024, sb = b % 1024, swz = sb ^ (((sb >> 9) & 1) << 5); R = (st >> 1) * 16 + swz / 64; C = (st & 1) * 32 + (swz % 64) / 2; }
__host__ __device__ __forceinline__ int perm32(int rho) { const int n = rho >> 4, i = rho & 15; return 8 * (i >> 2) + 4 * n + (i & 3); }

struct Unit { int pm, pn, z; };
struct Gemm { const bf16_t* A; const bf16_t* Bt; int M, N, K; const bf16_t* A2; const bf16_t* Bt2; };

struct StaticOrder {
    int nM, nN, nwg, G, c;
    __host__ __device__ void init(int M, int N, int G_, int c_) { nM = M / BM; nN = N / BM; nwg = nM * nN; G = G_; c = c_; }
    __host__ __device__ bool next(int i, Unit& u) const {
        const long L = (long)i * G + c; if (L >= nwg) return false;
        int wgid = (int)L; { const int q = nwg / NXCD, r = nwg % NXCD, xcd = wgid % NXCD, off = wgid / NXCD; wgid = (xcd < r ? xcd * (q + 1) : r * (q + 1) + (xcd - r) * q) + off; }
        const int nig = WGM * nN, gid = wgid / nig, fm = gid * WGM, gsz = (nM - fm) < WGM ? (nM - fm) : WGM;
        u.pm = fm + ((wgid % nig) % gsz); u.pn = (wgid % nig) / gsz; u.z = 0; return true;
    }
    __device__ __forceinline__ void a_ready(const Unit&) const {}
    __device__ __forceinline__ void done(const Unit&) const {}
};

__device__ __forceinline__ unsigned cvt_pk_bf16(float lo, float hi) { unsigned r; asm volatile("v_cvt_pk_bf16_f32 %0, %1, %2" : "=v"(r) : "v"(lo), "v"(hi)); return r; }
typedef float f32x2 __attribute__((ext_vector_type(2)));
__device__ __forceinline__ f32x2 gelu_pk(f32x2 v) {
    const f32x2 av = __builtin_elementwise_abs(v), d = av * 0.2316418882f + 1.0f;
    f32x2 t; t.x = __builtin_amdgcn_rcpf(d.x); t.y = __builtin_amdgcn_rcpf(d.y);
    f32x2 q = t * 0.5307027145f + (-0.7265760135f); q = q * t + 0.7107068705f; q = q * t + (-0.142248368f); q = q * t + 0.127414796f; q = q * t;
    const f32x2 s = (v * v) * (-0.72134752044f);
    f32x2 e; e.x = __builtin_amdgcn_exp2f(s.x); e.y = __builtin_amdgcn_exp2f(s.y);
    const f32x2 m = v * (q * e), r = v - m;
    f32x2 o; o.x = v.x < 0.f ? m.x : r.x; o.y = v.y < 0.f ? m.y : r.y; return o;
}

typedef unsigned u32x2 __attribute__((ext_vector_type(2)));
struct EpiSwiglu {
    static constexpr bool PERM = true, AFTER_DRAIN = false;
    bf16_t* H; int ldh; const float* rowss;
    __device__ __forceinline__ void operator()(const f32x4 (&acc)[2][2][4][2], const Unit& u, int wr, int wc, int fr, int fq) const {
        const int row0 = u.pm * BM + wr * 64 + fr, col0 = u.pn * HALF + wc * 32 + 8 * fq;
#pragma unroll
        for (int ai = 0; ai < 2; ++ai)
#pragma unroll
            for (int m = 0; m < 4; ++m) { bf16_t* rowp = H + (size_t)(row0 + ai * HALF + m * 16) * ldh + col0;
                const float rs = rowss ? 1.0f / sqrtf(__hip_atomic_load(rowss + row0 + ai * HALF + m * 16, __ATOMIC_RELAXED, __HIP_MEMORY_SCOPE_AGENT) * (1.0f / 1024.0f) + 1e-6f) : 1.0f;
                float o[8];
#pragma unroll
                for (int n = 0; n < 2; ++n)
#pragma unroll
                    for (int e = 0; e < 4; ++e) { const float g = acc[ai][0][m][n][e] * rs, up = acc[ai][1][m][n][e] * rs;
                        const float sg = g * __builtin_amdgcn_rcpf(1.0f + __builtin_amdgcn_exp2f(-1.4426950408889634f * g)); o[n * 4 + e] = sg * up; }
                u32x4 w; w.x = cvt_pk_bf16(o[0], o[1]); w.y = cvt_pk_bf16(o[2], o[3]); w.z = cvt_pk_bf16(o[4], o[5]); w.w = cvt_pk_bf16(o[6], o[7]);
                *(u32x4*)rowp = w; }
    }
};
struct EpiResid {
    static constexpr bool PERM = false, AFTER_DRAIN = false;
    const float* base; float* out; int ldc; float scale;
    bf16_t* xn; const float* gain; float* rowss;
    __device__ __forceinline__ void operator()(const f32x4 (&acc)[2][2][4][2], const Unit& u, int wr, int wc, int fr, int fq) const {
        const int row0 = u.pm * BM + wr * 64 + fr, col0 = u.pn * BM + wc * 32 + 4 * fq;
        f32x4 gv[2][2];
#pragma unroll
        for (int bj = 0; bj < 2; ++bj)
#pragma unroll
            for (int n = 0; n < 2; ++n) gv[bj][n] = xn ? *(const f32x4*)(gain + col0 + bj * HALF + n * 16) : (f32x4){1.f, 1.f, 1.f, 1.f};
#pragma unroll
        for (int ai = 0; ai < 2; ++ai)
#pragma unroll
            for (int m = 0; m < 4; ++m) { const size_t off = (size_t)(row0 + ai * HALF + m * 16) * ldc + col0; float ss = 0.f;
#pragma unroll
                for (int bj = 0; bj < 2; ++bj)
#pragma unroll
                    for (int n = 0; n < 2; ++n) { const f32x4 bs = *(const f32x4*)(base + off + bj * HALF + n * 16);
                        const f32x4 o = bs + acc[ai][bj][m][n] * scale;
                        *(f32x4*)(out + off + bj * HALF + n * 16) = o;
                        ss += (o[0] * o[0] + o[1] * o[1]) + (o[2] * o[2] + o[3] * o[3]);
                        if (xn) { const f32x4 t = o * gv[bj][n]; u32x2 w; w.x = cvt_pk_bf16(t[0], t[1]); w.y = cvt_pk_bf16(t[2], t[3]); *(u32x2*)(xn + off + bj * HALF + n * 16) = w; } }
                if (rowss) { ss += __shfl_xor(ss, 16); ss += __shfl_xor(ss, 32); if (fq == 0) atomicAdd(rowss + row0 + ai * HALF + m * 16, ss); } }
    }
};
struct EpiStore2 {
    static constexpr bool PERM = true, AFTER_DRAIN = false;
    bf16_t* O0; int ld0; bf16_t* O1; int ld1; const float* tokss;
    __device__ __forceinline__ void operator()(const f32x4 (&acc)[2][2][4][2], const Unit& u, int wr, int wc, int fr, int fq) const {
        bf16_t* O = u.z ? O1 : O0; const int ldc = u.z ? ld1 : ld0;
        const int row0 = u.pm * BM + wr * 64 + fr, col0 = u.pn * BM + wc * 32 + 8 * fq;
        f32x4 cs[2][2];
        if (u.z == 0) {
#pragma unroll
            for (int bj = 0; bj < 2; ++bj)
#pragma unroll
                for (int n = 0; n < 2; ++n) { f32x4 t;
#pragma unroll
                    for (int e = 0; e < 4; ++e) t[e] = 1.0f / sqrtf(__hip_atomic_load(tokss + col0 + bj * HALF + 4 * n + e, __ATOMIC_RELAXED, __HIP_MEMORY_SCOPE_AGENT) * (1.0f / 1024.0f) + 1e-6f);
                    cs[bj][n] = t; }
        } else { cs[0][0] = cs[0][1] = cs[1][0] = cs[1][1] = (f32x4){1.f, 1.f, 1.f, 1.f}; }
#pragma unroll
        for (int ai = 0; ai < 2; ++ai)
#pragma unroll
            for (int m = 0; m < 4; ++m) { bf16_t* rowp = O + (size_t)(row0 + ai * HALF + m * 16) * ldc + col0;
                const float rs = u.z ? 1.0f / sqrtf(__hip_atomic_load(tokss + row0 + ai * HALF + m * 16, __ATOMIC_RELAXED, __HIP_MEMORY_SCOPE_AGENT) * (1.0f / 1024.0f) + 1e-6f) : 1.0f;
#pragma unroll
                for (int bj = 0; bj < 2; ++bj) { const f32x4 v0 = acc[ai][bj][m][0] * cs[bj][0] * rs, v1 = acc[ai][bj][m][1] * cs[bj][1] * rs;
                    u32x4 w; w.x = cvt_pk_bf16(v0[0], v0[1]); w.y = cvt_pk_bf16(v0[2], v0[3]); w.z = cvt_pk_bf16(v1[0], v1[1]); w.w = cvt_pk_bf16(v1[2], v1[3]);
                    *(u32x4*)(rowp + bj * HALF) = w; } }
    }
};
struct WinOrder {
    StaticOrder so;
    __host__ __device__ void init(int G_, int c_) { so.init(64 * BM, 12 * BM, G_, c_); }
    __host__ __device__ bool next(int i, Unit& u) const {
        Unit v; if (!so.next(i, v)) return false;
        if (v.pn < 6) { u.pm = v.pn; u.pn = v.pm; u.z = 0; } else { u.pm = v.pm; u.pn = v.pn - 6; u.z = 1; }
        return true;
    }
    __device__ __forceinline__ void a_ready(const Unit&) const {}
    __device__ __forceinline__ void done(const Unit&) const {}
};
template <class Epi, class Sched, bool ALIGN_EPI = false, bool SP2 = false>
__device__ __forceinline__ void gemm_phase(PG8_LAS unsigned char* lds, const Gemm g, const Sched& S, const Epi& E) {
    int tid_ = threadIdx.x; asm volatile("" : "+v"(tid_));
    const int tid = tid_, wid = __builtin_amdgcn_readfirstlane(tid >> 6), lane = tid & 63, wr = wid >> 2, wc = wid & 3, fr = lane & 15, fq = lane >> 4;
    const int K = g.K, nt = K / BK;
    unsigned voffA[2], voffB[2];
#pragma unroll
    for (int i = 0; i < 2; ++i) { int R, C; stage_rc(tid * 16 + i * 8192, R, C); const int Rb = Epi::PERM ? ((R & ~31) + perm32(R & 31)) : R;
        voffA[i] = (unsigned)(R * K + C) * 2u; voffB[i] = (unsigned)(Rb * K + C) * 2u; }
    const size_t kstep = (size_t)(BK * 2);
    const size_t hstep = (size_t)HALF * K * 2;
    const size_t tstep = 2 * hstep;
    const unsigned ldsw = (unsigned)wid * 1024u;
    const int aoff = lds_byte(wr * 64 + fr, fq * 8), boff = lds_byte(wc * 32 + fr, fq * 8);
#define PG8_SA(b, h) (((b) * 2 + (h)) * HTB)
#define PG8_SB(b, h) ((4 + (b) * 2 + (h)) * HTB)
#define PG8_STAGE(bufoff, gbase, voff) do { _Pragma("unroll") for (int _i = 0; _i < 2; ++_i) \
        __builtin_amdgcn_global_load_lds((const unsigned*)((const char*)(gbase) + (voff)[_i]), (PG8_LAS unsigned*)(lds + (bufoff) + ldsw + _i * 8192), 16, 0, 0); } while (0)
#define PG8_LDA(dst, b, h) do { _Pragma("unroll") for (int m = 0; m < 4; ++m) _Pragma("unroll") for (int k = 0; k < 2; ++k) dst[m][k] = *(const PG8_LAS bf16x8*)(lds + PG8_SA(b, h) + aoff + m * 2048 + k * 1024); } while (0)
#define PG8_LDB(dst, b, h) do { _Pragma("unroll") for (int n = 0; n < 2; ++n) _Pragma("unroll") for (int k = 0; k < 2; ++k) dst[n][k] = *(const PG8_LAS bf16x8*)(lds + PG8_SB(b, h) + boff + n * 2048 + k * 1024); } while (0)
#define PG8_MMA(ai, bj, At, Bt) do { __builtin_amdgcn_s_setprio(1); _Pragma("unroll") for (int m = 0; m < 4; ++m) _Pragma("unroll") for (int n = 0; n < 2; ++n) _Pragma("unroll") for (int k = 0; k < 2; ++k) \
        acc[ai][bj][m][n] = __builtin_amdgcn_mfma_f32_16x16x32_bf16(Bt[n][k], At[m][k], acc[ai][bj][m][n], 0, 0, 0); __builtin_amdgcn_s_setprio(0); } while (0)
#define PG8_WAIT_V(n) asm volatile("s_waitcnt vmcnt(" #n ")" ::: "memory")
#define PG8_WAIT_L(n) asm volatile("s_waitcnt lgkmcnt(" #n ")" ::: "memory")
#define PG8_BAR __builtin_amdgcn_s_barrier()
#define PG8_SCHED __builtin_amdgcn_sched_barrier(0)
    Unit cur, nxt; int ui = 0;
    if (!S.next(0, cur)) return;
    f32x4 acc[2][2][4][2];
#pragma unroll
    for (int a = 0; a < 2; ++a)
#pragma unroll
        for (int b = 0; b < 2; ++b)
#pragma unroll
            for (int m = 0; m < 4; ++m)
#pragma unroll
                for (int n = 0; n < 2; ++n) acc[a][b][m][n] = (f32x4){0.f, 0.f, 0.f, 0.f};
    bf16x8 At[4][2], B0[2][2], B1[2][2];
    const char* cA = (const char*)(cur.z ? g.A2 : g.A) + (size_t)cur.pm * tstep; const char* cB = (const char*)(cur.z ? g.Bt2 : g.Bt) + (size_t)cur.pn * tstep;
    S.a_ready(cur);
    if constexpr (SP2) {
        PG8_STAGE(PG8_SB(0, 0), cB, voffB); PG8_STAGE(PG8_SB(0, 1), cB + hstep, voffB); PG8_STAGE(PG8_SA(0, 0), cA, voffA); PG8_STAGE(PG8_SA(0, 1), cA + hstep, voffA);
        if (wr == 1) PG8_BAR;
        PG8_WAIT_V(2); PG8_BAR;
        PG8_STAGE(PG8_SB(1, 0), cB + kstep, voffB); PG8_STAGE(PG8_SA(1, 0), cA + kstep, voffA); PG8_STAGE(PG8_SB(1, 1), cB + hstep + kstep, voffB);
        PG8_WAIT_V(6); PG8_BAR;
    } else {
        PG8_STAGE(PG8_SB(0, 0), cB, voffB); PG8_STAGE(PG8_SA(0, 0), cA, voffA); PG8_STAGE(PG8_SB(0, 1), cB + hstep, voffB); PG8_STAGE(PG8_SA(0, 1), cA + hstep, voffA);
        if (wr == 1) PG8_BAR;
        PG8_WAIT_V(4); PG8_BAR;
        PG8_STAGE(PG8_SB(1, 0), cB + kstep, voffB); PG8_STAGE(PG8_SA(1, 0), cA + kstep, voffA); PG8_STAGE(PG8_SB(1, 1), cB + hstep + kstep, voffB);
        PG8_WAIT_V(6); PG8_BAR;
    }
    for (;;) {
        const bool has_next = S.next(ui + 1, nxt);
        const char* nA = has_next ? (const char*)(nxt.z ? g.A2 : g.A) + (size_t)nxt.pm * tstep : cA; const char* nB = has_next ? (const char*)(nxt.z ? g.Bt2 : g.Bt) + (size_t)nxt.pn * tstep : cB;
        for (int t = 0; t < nt; t += 2) {
            const bool last = (t == nt - 2);
            const char* a1 = cA + (size_t)(t + 1) * kstep;
            const char* a2 = last ? nA : cA + (size_t)(t + 2) * kstep; const char* b2 = last ? nB : cB + (size_t)(t + 2) * kstep;
            const char* a3 = a2 + kstep; const char* b3 = b2 + kstep;
            if (last && has_next) S.a_ready(nxt);
            if constexpr (SP2) {
            PG8_LDB(B0, 0, 0); PG8_LDB(B1, 0, 1); PG8_SCHED; PG8_LDA(At, 0, 0); PG8_STAGE(PG8_SA(1, 1), a1 + hstep, voffA);
            PG8_WAIT_V(8); PG8_WAIT_L(0); PG8_BAR; PG8_MMA(0, 0, At, B0); PG8_MMA(0, 1, At, B1); PG8_BAR; PG8_SCHED;
            PG8_LDA(At, 0, 1); PG8_STAGE(PG8_SB(0, 0), b2, voffB); PG8_STAGE(PG8_SB(0, 1), b2 + hstep, voffB); PG8_STAGE(PG8_SA(0, 0), a2, voffA);
            PG8_WAIT_V(8); PG8_WAIT_L(0); PG8_BAR; PG8_MMA(1, 0, At, B0); PG8_MMA(1, 1, At, B1); PG8_BAR; PG8_SCHED;
            PG8_LDB(B0, 1, 0); PG8_LDB(B1, 1, 1); PG8_SCHED; PG8_LDA(At, 1, 0); PG8_STAGE(PG8_SA(0, 1), a2 + hstep, voffA);
            PG8_WAIT_V(8); PG8_WAIT_L(0); PG8_BAR; PG8_MMA(0, 0, At, B0); PG8_MMA(0, 1, At, B1); PG8_BAR; PG8_SCHED;
            PG8_LDA(At, 1, 1); PG8_STAGE(PG8_SB(1, 0), b3, voffB); PG8_STAGE(PG8_SB(1, 1), b3 + hstep, voffB); PG8_STAGE(PG8_SA(1, 0), a3, voffA);
            PG8_WAIT_V(8); PG8_WAIT_L(0); PG8_BAR; PG8_MMA(1, 0, At, B0); PG8_MMA(1, 1, At, B1); PG8_BAR; PG8_SCHED;
            } else {
            PG8_LDB(B0, 0, 0); PG8_SCHED; PG8_LDA(At, 0, 0); PG8_STAGE(PG8_SA(1, 1), a1 + hstep, voffA);
            PG8_WAIT_L(8); PG8_BAR; PG8_WAIT_L(0); PG8_MMA(0, 0, At, B0); PG8_BAR; PG8_SCHED;
            PG8_LDB(B1, 0, 1); PG8_STAGE(PG8_SB(0, 0), b2, voffB);
            PG8_BAR; PG8_WAIT_L(0); PG8_MMA(0, 1, At, B1); PG8_BAR;
            PG8_LDA(At, 0, 1); PG8_STAGE(PG8_SA(0, 0), a2, voffA);
            PG8_BAR; PG8_WAIT_L(0); PG8_MMA(1, 0, At, B0); PG8_BAR; PG8_SCHED;
            PG8_STAGE(PG8_SB(0, 1), b2 + hstep, voffB);
            PG8_WAIT_V(6); PG8_BAR; PG8_MMA(1, 1, At, B1); PG8_BAR;
            PG8_LDB(B0, 1, 0); PG8_SCHED; PG8_LDA(At, 1, 0); PG8_STAGE(PG8_SA(0, 1), a2 + hstep, voffA);
            PG8_WAIT_L(8); PG8_BAR; PG8_WAIT_L(0); PG8_MMA(0, 0, At, B0); PG8_BAR; PG8_SCHED;
            PG8_LDB(B1, 1, 1); PG8_STAGE(PG8_SB(1, 0), b3, voffB);
            PG8_BAR; PG8_WAIT_L(0); PG8_MMA(0, 1, At, B1); PG8_BAR;
            PG8_LDA(At, 1, 1); PG8_STAGE(PG8_SA(1, 0), a3, voffA);
            PG8_BAR; PG8_WAIT_L(0); PG8_MMA(1, 0, At, B0); PG8_BAR; PG8_SCHED;
            PG8_STAGE(PG8_SB(1, 1), b3 + hstep, voffB);
            PG8_WAIT_V(6); PG8_BAR; PG8_MMA(1, 1, At, B1); PG8_BAR;
            }
        }
        if constexpr (ALIGN_EPI) { if (wr == 0) PG8_BAR; }
        if constexpr (!Epi::AFTER_DRAIN) { E(acc, cur, wr, wc, fr, fq); S.done(cur); }
        if (!has_next) break;
#pragma unroll
        for (int a = 0; a < 2; ++a)
#pragma unroll
            for (int b = 0; b < 2; ++b)
#pragma unroll
                for (int m = 0; m < 4; ++m)
#pragma unroll
                    for (int n = 0; n < 2; ++n) acc[a][b][m][n] = (f32x4){0.f, 0.f, 0.f, 0.f};
        cur = nxt; cA = nA; cB = nB; ++ui;
        if constexpr (ALIGN_EPI) { if (wr == 1) PG8_BAR; }
    }
    PG8_WAIT_V(0);
    if constexpr (!ALIGN_EPI) { if (wr == 0) PG8_BAR; }
    PG8_BAR;
    if constexpr (Epi::AFTER_DRAIN) { E.fused(acc, cur, wr, wc, fr, fq, lds, wid, lane); S.done(cur); }
#undef PG8_SA
#undef PG8_SB
#undef PG8_STAGE
#undef PG8_LDA
#undef PG8_LDB
#undef PG8_MMA
#undef PG8_WAIT_V
#undef PG8_WAIT_L
#undef PG8_BAR
#undef PG8_SCHED
}
}
constexpr int NWAVES = 8;
constexpr int M = 16384, D = 1024, FF = 2816, NBATCH = 8, SEQ = 2048, DH = 512, NQKV = 1536;
constexpr float RMS_EPS = 1e-6f;
constexpr int LDS_BYTES = 147456;
constexpr size_t MiB = 1u << 20;
constexpr size_t WS_W1A = 0, WS_W1D = 11 * MiB, WS_WIN = 17 * MiB, WS_WOUT = 23 * MiB, WS_W2A = 25 * MiB, WS_W2D = 36 * MiB;
constexpr size_t WS_XN = 42 * MiB;
constexpr size_t WS_H = 74 * MiB;
constexpr size_t WS_PT = 74 * MiB;
constexpr size_t WS_QKV = 122 * MiB;
constexpr size_t WS_YHT = 170 * MiB;
constexpr size_t WS_YA = 186 * MiB;
constexpr size_t WS_Y = 202 * MiB;
constexpr size_t WS_G = 234 * MiB;
constexpr size_t WS_SS = 242 * MiB;
constexpr size_t WS_BAR = 243 * MiB;
constexpr size_t WS_END = 244 * MiB;

#define LAS __attribute__((address_space(3)))
typedef unsigned short bf16;
typedef float f32x4 __attribute__((ext_vector_type(4)));
typedef unsigned u32x4 __attribute__((ext_vector_type(4)));
using pg8::u32x2;
typedef short bf16x8 __attribute__((ext_vector_type(8)));
typedef short s16x4 __attribute__((ext_vector_type(4)));
#define LDS_WAIT() asm volatile("s_waitcnt lgkmcnt(0)" ::: "memory")
using pg8::cvt_pk_bf16;
__device__ __forceinline__ float bf2f(unsigned v) { return __uint_as_float(v << 16); }
__device__ __forceinline__ unsigned f2bf(float f) { return cvt_pk_bf16(f, 0.f) & 0xffffu; }
__device__ __forceinline__ float wave_sum(float v) {
#pragma unroll
    for (int o = 1; o < 64; o <<= 1) v += __shfl_xor(v, o);
    return v;
}

struct Params { const float* in[26]; float* out; unsigned char* ws; };
enum { I_X = 0, I_G1, I_WG1, I_WU1, I_WD1, I_GMIX, I_WIN, I_CW, I_CB, I_FW1, I_FB1, I_FW2, I_FB2, I_FW3, I_FB3, I_FWO, I_FREQ, I_SKIP, I_GHY, I_GAT, I_WOUT, I_G2, I_WG2, I_WU2, I_WD2, I_GFIN };

__device__ __forceinline__ void p0_transpose_item(const float* W, int K, int N, bf16* WT, int k0, int n0, int drow0, LAS float* scr, int lane) {
    float tv[32];
    const float* wp = W + (size_t)(k0 + (lane >> 5)) * N + n0 + (lane & 31);
#pragma unroll
    for (int i = 0; i < 32; ++i) tv[i] = wp[(size_t)(2 * i) * N];
#pragma unroll
    for (int i = 0; i < 32; ++i) scr[(2 * i + (lane >> 5)) * 33 + (lane & 31)] = tv[i];
    LDS_WAIT();
    const int c = lane & 7;
#pragma unroll
    for (int j = 0; j < 4; ++j) { const int n = (lane >> 3) + 8 * j; const LAS float* s = scr + (8 * c) * 33 + n;
        u32x4 o; o.x = cvt_pk_bf16(s[0 * 33], s[1 * 33]); o.y = cvt_pk_bf16(s[2 * 33], s[3 * 33]); o.z = cvt_pk_bf16(s[4 * 33], s[5 * 33]); o.w = cvt_pk_bf16(s[6 * 33], s[7 * 33]);
        *(u32x4*)(WT + (size_t)(drow0 + n) * K + k0 + 8 * c) = o; }
    LDS_WAIT();
}
__device__ __forceinline__ void p0_transpose_mat(const float* W, int K, int N, bf16* WT, int mode, int item, LAS float* scr, int lane) {
    const int nblk = N / 32, kb = item / nblk, nb = item % nblk, n0 = 32 * nb;
    const int drow0 = mode == 0 ? n0 : (256 * (n0 / 128) + (n0 % 128) + (mode == 2 ? 128 : 0));
    p0_transpose_item(W, K, N, WT, 64 * kb, n0, drow0, scr, lane);
}
__device__ __forceinline__ void rms_row_to_bf16(const float* xrow, const float* g, bf16* orow, int lane) {
    const f32x4* xr = (const f32x4*)xrow + lane; const f32x4* gr = (const f32x4*)g + lane;
    f32x4 v[4]; float s = 0.f;
#pragma unroll
    for (int j = 0; j < 4; ++j) { v[j] = xr[64 * j]; s += (v[j].x * v[j].x + v[j].y * v[j].y) + (v[j].z * v[j].z + v[j].w * v[j].w); }
    const float rstd = 1.0f / sqrtf(wave_sum(s) * (1.f / D) + RMS_EPS);
    u32x2* o8 = (u32x2*)orow + lane;
#pragma unroll
    for (int j = 0; j < 4; ++j) { const f32x4 gv = gr[64 * j]; u32x2 w; w.x = cvt_pk_bf16(v[j].x * rstd * gv.x, v[j].y * rstd * gv.y); w.y = cvt_pk_bf16(v[j].z * rstd * gv.z, v[j].w * rstd * gv.w); o8[64 * j] = w; }
}
__device__ __forceinline__ void rms_row_to_f32_ss(const float* xrow, const float* g, float* orow, float ss, int lane) {
    const f32x4* xr = (const f32x4*)xrow + lane; const f32x4* gr = (const f32x4*)g + lane;
    const float rstd = 1.0f / sqrtf(ss * (1.f / D) + RMS_EPS);
    f32x4* o = (f32x4*)orow + lane;
#pragma unroll
    for (int j = 0; j < 4; ++j) { const f32x4 gv = gr[64 * j]; o[64 * j] = xr[64 * j] * rstd * gv; }
}
__device__ __forceinline__ void rms_row_to_f32(const float* xrow, const float* g, float* orow, int lane) {
    const f32x4* xr = (const f32x4*)xrow + lane; const f32x4* gr = (const f32x4*)g + lane;
    f32x4 v[4]; float s = 0.f;
#pragma unroll
    for (int j = 0; j < 4; ++j) { v[j] = xr[64 * j]; s += (v[j].x * v[j].x + v[j].y * v[j].y) + (v[j].z * v[j].z + v[j].w * v[j].w); }
    const float rstd = 1.0f / sqrtf(wave_sum(s) * (1.f / D) + RMS_EPS);
    f32x4* o = (f32x4*)orow + lane;
#pragma unroll
    for (int j = 0; j < 4; ++j) { const f32x4 gv = gr[64 * j]; o[64 * j] = v[j] * rstd * gv; }
}

__device__ __forceinline__ void filt_gen(const Params& p, LAS unsigned char* lds, int tid) {
    const int wave = tid >> 6, j = tid & 63;
    LAS float* zb = (LAS float*)lds + wave * 192; LAS float* ha = zb + 64; LAS float* hb = zb + 128;
    LAS float* w1l = (LAS float*)(lds + 8192); LAS float* w2l = w1l + 33 * 64; LAS float* w3l = w2l + 64 * 64; LAS float* h3l = w3l + 64 * 64;
    bf16* G = (bf16*)(p.ws + WS_G);
    for (int i = tid; i < 33 * 64; i += NWAVES * 64) w1l[i] = p.in[I_FW1][i];
    for (int i = tid; i < 64 * 64; i += NWAVES * 64) { w2l[i] = p.in[I_FW2][i]; w3l[i] = p.in[I_FW3][i]; }
    const float fq = p.in[I_FREQ][j], b1 = p.in[I_FB1][j], b2 = p.in[I_FB2][j], b3 = p.in[I_FB3][j];
    __syncthreads();
    for (int base = blockIdx.x * 8; base < SEQ; base += gridDim.x * 8) {
        const int pos = base + wave;
        const float tl = (float)pos / 2047.0f, w = (6.283185307179586f * (float)pos) / 2048.0f;
        if (j < 33) { float z; if (j == 0) z = tl; else { const int i = (j - 1) & 15; const float f = 1e-4f + (float)i * ((15.0f - 1e-4f) / 15.0f); z = (j <= 16) ? cosf(f * w) : -sinf(f * w); } zb[j] = z; }
        __syncthreads();
        { float a = b1;
#pragma unroll
          for (int i = 0; i < 33; ++i) a += zb[i] * w1l[i * 64 + j];
          ha[j] = sinf(fq * a); }
        __syncthreads();
        { float a = b2;
#pragma unroll
          for (int i = 0; i < 64; ++i) a += ha[i] * w2l[i * 64 + j];
          hb[j] = sinf(fq * a); }
        __syncthreads();
        { float a = b3;
#pragma unroll
          for (int i = 0; i < 64; ++i) a += hb[i] * w3l[i * 64 + j];
          h3l[wave * 64 + j] = sinf(fq * a); }
        __syncthreads();
        float acc[4][8];
#pragma unroll
        for (int q = 0; q < 4; ++q)
#pragma unroll
            for (int pp = 0; pp < 8; ++pp) acc[q][pp] = 0.f;
        const float* wo = p.in[I_FWO] + tid;
#pragma unroll 2
        for (int j4 = 0; j4 < 16; ++j4) {
            f32x4 hv[8];
#pragma unroll
            for (int pp = 0; pp < 8; ++pp) hv[pp] = *(const LAS f32x4*)(h3l + pp * 64 + 4 * j4);
#pragma unroll
            for (int q = 0; q < 4; ++q) { const float* wq = wo + (size_t)(4 * j4) * 2048 + 512 * q;
                const float w0 = wq[0], w1 = wq[2048], w2 = wq[4096], w3 = wq[6144];
#pragma unroll
                for (int pp = 0; pp < 8; ++pp) acc[q][pp] += (hv[pp].x * w0 + hv[pp].y * w1) + (hv[pp].z * w2 + hv[pp].w * w3); }
        }
#pragma unroll
        for (int q = 0; q < 4; ++q) { const int col = tid + 512 * q, o = col >> 10, dir = (col >> 9) & 1, c = col & 511;
            const float ad = 3.0701134573253943f + (float)c * ((15.350567286626972f - 3.0701134573253943f) / 511.0f);
            bf16* gp = G + (size_t)(c * 2 + o) * 4096;
            float v[8];
#pragma unroll
            for (int pp = 0; pp < 8; ++pp) v[pp] = acc[q][pp] * expf(-((float)(base + pp) / 2047.0f) * ad);
            if (dir == 0) { u32x4 w4; w4.x = cvt_pk_bf16(v[0], v[1]); w4.y = cvt_pk_bf16(v[2], v[3]); w4.z = cvt_pk_bf16(v[4], v[5]); w4.w = cvt_pk_bf16(v[6], v[7]); *(u32x4*)(gp + 2048 + base) = w4; }
            else {
#pragma unroll
                for (int pp = 0; pp < 8; ++pp) { if (base + pp > 0) gp[2048 - base - pp] = (bf16)f2bf(v[pp]); else gp[0] = 0; } }
        }
        __syncthreads();
    }
}

__device__ __forceinline__ float sconv(const bf16* row, int t, float w0, float w1, float w2, float bias) {
    float a = bias + w1 * bf2f(row[t]);
    if (t > 0) a += w0 * bf2f(row[t - 1]);
    if (t < SEQ - 1) a += w2 * bf2f(row[t + 1]);
    return a;
}
__device__ __forceinline__ void conv_unit_scalar(const Params& p, LAS unsigned char* lds, int c, int tid) {
    LAS float* g = (LAS float*)lds;
    LAS bf16* zA = (LAS bf16*)(lds + 16384);
    LAS bf16* zB = (LAS bf16*)(lds + 16384 + 32768);
    const bf16* PT = (const bf16*)(p.ws + WS_PT); const bf16* G = (const bf16*)(p.ws + WS_G); bf16* YHT = (bf16*)(p.ws + WS_YHT);
    const float* cw = p.in[I_CW]; const float* cb = p.in[I_CB];
    float x1c[4][8], x2c[4][8];
    {
        const float v0 = cw[c], v1 = cw[1536 + c], v2 = cw[3072 + c], vb = cb[c];
        const float a0 = cw[512 + c], a1 = cw[1536 + 512 + c], a2 = cw[3072 + 512 + c], ab = cb[512 + c];
        const float b0 = cw[1024 + c], b1 = cw[1536 + 1024 + c], b2 = cw[3072 + 1024 + c], bb = cb[1024 + c];
#pragma unroll
        for (int k = 0; k < 4; ++k)
#pragma unroll
            for (int b = 0; b < 8; ++b) { const int t = tid + 512 * k;
                zA[b * 2048 + t] = (bf16)f2bf(sconv(PT + (size_t)c * M + b * SEQ, t, v0, v1, v2, vb));
                x1c[k][b] = sconv(PT + (size_t)(512 + c) * M + b * SEQ, t, a0, a1, a2, ab);
                x2c[k][b] = sconv(PT + (size_t)(1024 + c) * M + b * SEQ, t, b0, b1, b2, bb); }
    }
    for (int o = 0; o < 2; ++o) {
        __syncthreads();
#pragma unroll
        for (int e = 0; e < 8; ++e) { const int idx = tid + 512 * e; g[idx] = bf2f(G[(size_t)(c * 2 + o) * 4096 + idx]); }
        __syncthreads();
        const LAS bf16* zin = o ? zB : zA;
        float acc[4][8];
#pragma unroll
        for (int k = 0; k < 4; ++k)
#pragma unroll
            for (int b = 0; b < 8; ++b) acc[k][b] = 0.f;
        for (int s = 0; s < SEQ; ++s) {
            float zv[8];
#pragma unroll
            for (int b = 0; b < 8; ++b) zv[b] = bf2f(zin[b * 2048 + s]);
#pragma unroll
            for (int k = 0; k < 4; ++k) { const float gv = g[2048 + tid + 512 * k - s];
#pragma unroll
                for (int b = 0; b < 8; ++b) acc[k][b] += gv * zv[b]; }
        }
        const float skip = p.in[I_SKIP][o * 512 + c];
#pragma unroll
        for (int k = 0; k < 4; ++k)
#pragma unroll
            for (int b = 0; b < 8; ++b) { const int t = tid + 512 * k; const float y = acc[k][b] + bf2f(zin[b * 2048 + t]) * skip;
                if (o == 0) zB[b * 2048 + t] = (bf16)f2bf(x1c[k][b] * y); else YHT[(size_t)c * M + b * SEQ + t] = (bf16)f2bf(x2c[k][b] * y); }
    }
    __syncthreads();
}
#define XB_TMO      128
#define XB_XCNT(j)  (256  + 64 * (j))
#define XB_XSUB(j)  (1280 + 64 * (j))
#define XB_XGEN(j)  (2304 + 64 * (j))
#define XB_TOP      3328
#define XB_TOPGEN   3392
#define XCD_BAR_WORDS 3456
#define XB_SPIN_CAP (1u << 18)

__device__ __forceinline__ unsigned xb_ld(unsigned* p)              { return __hip_atomic_load(p, __ATOMIC_RELAXED, __HIP_MEMORY_SCOPE_AGENT); }
__device__ __forceinline__ unsigned xb_add(unsigned* p, unsigned v) { return __hip_atomic_fetch_add(p, v, __ATOMIC_RELAXED, __HIP_MEMORY_SCOPE_AGENT); }
__device__ __forceinline__ unsigned xb_xcc_id() { return (unsigned)__builtin_amdgcn_s_getreg((3 << 11) | 20) & 0xFu; }
#define XB_SPIN(cond, bar) do { unsigned _sp = 0; while (cond) { __builtin_amdgcn_s_sleep(1); \
    if ((++_sp & 255u) == 0u) { if (xb_ld(&(bar)[XB_TMO])) break; if (_sp > XB_SPIN_CAP) { atomicAdd(&(bar)[XB_TMO], 1u); break; } } } } while (0)

struct XcdBarrier {
    unsigned* bar; unsigned x;
    volatile LAS unsigned* st;
};

__device__ __forceinline__ XcdBarrier xcd_barrier_post(unsigned* bar, volatile LAS unsigned* st) {
    XcdBarrier b; b.bar = bar; b.x = xb_xcc_id(); b.st = st;
    if (threadIdx.x == 0) (void)xb_add(&bar[XB_XCNT(b.x)], 1u);
    return b;
}
__device__ __forceinline__ void xcd_barrier_complete(unsigned* bar, unsigned x, unsigned& nloc, unsigned& nx) {
    const unsigned G = gridDim.x * gridDim.y * gridDim.z;
    unsigned sum, cnt, mine, sp = 0u;
    for (;;) {
        sum = 0u; cnt = 0u; mine = 0u;
#pragma unroll
        for (unsigned j = 0; j < 16; ++j) { const unsigned c = xb_ld(&bar[XB_XCNT(j)]); sum += c; cnt += (c > 0u) ? 1u : 0u; mine = (j == x) ? c : mine; }
        if (sum == G) break;
        __builtin_amdgcn_s_sleep(1);
        if ((++sp & 255u) == 0u) { if (xb_ld(&bar[XB_TMO])) break; if (sp > XB_SPIN_CAP) { atomicAdd(&bar[XB_TMO], 1u); break; } }
    }
    nloc = mine > 0u ? mine : 1u; nx = cnt > 0u ? cnt : 1u;
}

__device__ __forceinline__ void xcd_barrier(const XcdBarrier& b) {
    asm volatile("s_waitcnt vmcnt(0)" ::: "memory");
    __syncthreads();
    if (threadIdx.x == 0) {
        unsigned* bar = b.bar;
        __builtin_amdgcn_s_waitcnt(0);
        unsigned nloc = b.st[0], nx = b.st[1];
        if (nloc == 0u) { xcd_barrier_complete(bar, b.x, nloc, nx); b.st[0] = nloc; b.st[1] = nx; }
        const unsigned old = xb_add(&bar[XB_XSUB(b.x)], 1u);
        const unsigned gen = old / nloc;
        if (old + 1u == (gen + 1u) * nloc) {
            __builtin_amdgcn_fence(__ATOMIC_RELEASE, "agent");
            asm volatile("s_waitcnt vmcnt(0)" ::: "memory");
            const unsigned og = xb_add(&bar[XB_TOP], 1u);
            const unsigned tg = og / nx;
            if (og + 1u == (tg + 1u) * nx) xb_add(&bar[XB_TOPGEN], 1u);
            else XB_SPIN(xb_ld(&bar[XB_TOPGEN]) == tg, bar);
            __builtin_amdgcn_fence(__ATOMIC_ACQUIRE, "agent");
            xb_add(&bar[XB_XGEN(b.x)], 1u);
            asm volatile("s_waitcnt vmcnt(0)" ::: "memory");
        } else {
            XB_SPIN(xb_ld(&bar[XB_XGEN(b.x)]) == gen, bar);
            __builtin_amdgcn_fence(__ATOMIC_ACQUIRE, "agent");
            asm volatile("s_waitcnt vmcnt(0)" ::: "memory");
        }
    }
    __syncthreads();
}
constexpr int CV_GCS = 8224, CV_ZBLK = 79, CV_ZA = 8 * CV_GCS, CV_ZB = CV_ZA + CV_ZBLK * 512;
static_assert(CV_ZB + CV_ZBLK * 512 <= LDS_BYTES - 64, "conv LDS map");
__device__ __forceinline__ void conv_build_gc(LAS unsigned char* lds, int tid, const u32x4 lo, const u32x4 hi) {
    const unsigned d[8] = {lo.x, lo.y, lo.z, lo.w, hi.x, hi.y, hi.z, hi.w};
#pragma unroll
    for (int s = 0; s < 8; ++s) {
        unsigned w[4];
#pragma unroll
        for (int j = 0; j < 4; ++j) { const int x = 8 + s - 2 * j, m = x >> 1;
            if (x & 1) w[j] = __builtin_amdgcn_alignbit(d[m], d[m], 16);
            else w[j] = (d[m] & 0xffffu) | (d[m - 1] & 0xffff0000u); }
        *(LAS u32x4*)(lds + s * CV_GCS + tid * 16) = (u32x4){w[0], w[1], w[2], w[3]};
    }
}
__device__ __forceinline__ void conv_mma(LAS unsigned char* lds, int zoff, int wave, int lane, f32x4 (&acc)[4][2]) {
    const int fr = lane & 15, fq = lane >> 4;
    const int Dlo = 8 * wave - 63, Dhi = 8 * wave + 7;
    const LAS unsigned char* ap = lds + (fr & 7) * CV_GCS + (8 * fq - 8 * (fr >> 3) + 2048) * 2 - 64 * Dlo;
    const LAS unsigned char* zp = lds + zoff + ((fr >> 3) + 7 + 8 * wave - Dlo) * 512 + (fr & 7) * 64 + fq * 16;
#pragma unroll
    for (int jt = 0; jt < 4; ++jt) { acc[jt][0] = (f32x4){0.f, 0.f, 0.f, 0.f}; acc[jt][1] = (f32x4){0.f, 0.f, 0.f, 0.f}; }
    bf16x8 a0 = *(const LAS bf16x8*)ap, a1 = *(const LAS bf16x8*)(ap - 32), bE[4], bO[4];
#pragma unroll
    for (int jt = 0; jt < 4; ++jt) { bE[jt] = *(const LAS bf16x8*)(zp + 1024 * jt); bO[jt] = *(const LAS bf16x8*)(zp + 1024 * jt - 512); }
    constexpr int NI = 71;
#define CV_STEP(i, bS) do { \
        const int in_ = (i) + 1 < NI ? (i) + 1 : (i), i2_ = (i) + 2 < NI ? (i) + 2 : (i); \
        const bf16x8 na0 = *(const LAS bf16x8*)(ap - 64 * in_), na1 = *(const LAS bf16x8*)(ap - 64 * in_ - 32); \
        const bf16x8 nb0 = *(const LAS bf16x8*)(zp - 512 * i2_); \
        _Pragma("unroll") for (int jt = 0; jt < 4; ++jt) { \
            acc[jt][0] = __builtin_amdgcn_mfma_f32_16x16x32_bf16(a0, bS[jt], acc[jt][0], 0, 0, 0); \
            acc[jt][1] = __builtin_amdgcn_mfma_f32_16x16x32_bf16(a1, bS[jt], acc[jt][1], 0, 0, 0); } \
        a0 = na0; a1 = na1; bS[3] = bS[2]; bS[2] = bS[1]; bS[1] = bS[0]; bS[0] = nb0; } while (0)
#pragma unroll 2
    for (int i = 0; i < NI - 1; i += 2) { CV_STEP(i, bE); CV_STEP(i + 1, bO); }
    CV_STEP(NI - 1, bE);
#undef CV_STEP
}
__device__ __forceinline__ f32x4 sconv4(const bf16* row, int t0, float w0, float w1, float w2, float bias) {
    const u32x2 v = *(const u32x2*)(row + t0);
    const float c0 = bf2f(v.x & 0xffffu), c1 = bf2f(v.x >> 16), c2 = bf2f(v.y & 0xffffu), c3 = bf2f(v.y >> 16);
    const float pm = t0 > 0 ? bf2f(row[t0 - 1]) : 0.f, pp = t0 + 4 < SEQ ? bf2f(row[t0 + 4]) : 0.f;
    f32x4 o; o.x = bias + w0 * pm + w1 * c0 + w2 * c1; o.y = bias + w0 * c0 + w1 * c1 + w2 * c2; o.z = bias + w0 * c1 + w1 * c2 + w2 * c3; o.w = bias + w0 * c2 + w1 * c3 + w2 * pp;
    return o;
}
__device__ __forceinline__ void conv_unit_mfma(const Params& p, LAS unsigned char* lds, int c, int tid) {
    const int lane = tid & 63, wave = __builtin_amdgcn_readfirstlane(tid >> 6), fr = lane & 15, fq = lane >> 4, nb = fr >> 3, b = fr & 7;
    const bf16* PT = (const bf16*)(p.ws + WS_PT); const bf16* G = (const bf16*)(p.ws + WS_G); bf16* YHT = (bf16*)(p.ws + WS_YHT);
    const float* cw = p.in[I_CW]; const float* cb = p.in[I_CB];
    u32x4 glo[2], ghi[2];
#pragma unroll
    for (int o = 0; o < 2; ++o) { const bf16* gp = G + (size_t)(c * 2 + o) * 4096 + 4088 - 8 * tid; glo[o] = *(const u32x4*)gp;
        if (tid > 0) ghi[o] = *(const u32x4*)(gp + 8); else { unsigned zz; asm volatile("v_mov_b32 %0, 0" : "=v"(zz)); ghi[o] = (u32x4){zz, zz, zz, zz}; } }
    __syncthreads();
    { unsigned zz; asm volatile("v_mov_b32 %0, 0" : "=v"(zz));
#pragma unroll
        for (int k = 0; k < 2; ++k) { const int q = tid + 512 * k; if (q < 960) { const int z = q >= 480, r = q - 480 * z;
            *(LAS u32x4*)(lds + (z ? CV_ZB : CV_ZA) + (r < 224 ? r * 16 : 71 * 512 + (r - 224) * 16)) = (u32x4){zz, zz, zz, zz}; } } }
    f32x4 x1c[4][2], x2c[4][2];
    {
        const float v0 = cw[c], v1 = cw[1536 + c], v2 = cw[3072 + c], vb = cb[c];
        const float a0 = cw[512 + c], a1 = cw[1536 + 512 + c], a2 = cw[3072 + 512 + c], ab = cb[512 + c];
        const float b0 = cw[1024 + c], b1 = cw[1536 + 1024 + c], b2 = cw[3072 + 1024 + c], bb = cb[1024 + c];
#pragma unroll
        for (int jt = 0; jt < 4; ++jt)
#pragma unroll
            for (int h = 0; h < 2; ++h) { const int P = 8 * wave + 2 * jt + nb, t0 = 32 * P + 16 * h + 4 * fq;
                const f32x4 v = sconv4(PT + (size_t)c * M + b * SEQ, t0, v0, v1, v2, vb);
                u32x2 w; w.x = cvt_pk_bf16(v.x, v.y); w.y = cvt_pk_bf16(v.z, v.w);
                *(LAS u32x2*)(lds + CV_ZA + (P + 7) * 512 + b * 64 + (16 * h + 4 * fq) * 2) = w;
                x1c[jt][h] = sconv4(PT + (size_t)(512 + c) * M + b * SEQ, t0, a0, a1, a2, ab);
                x2c[jt][h] = sconv4(PT + (size_t)(1024 + c) * M + b * SEQ, t0, b0, b1, b2, bb); }
    }
#pragma unroll
    for (int o = 0; o < 2; ++o) {
        if (o == 1) __syncthreads();
        conv_build_gc(lds, tid, glo[o], ghi[o]);
        __syncthreads();
        f32x4 acc[4][2];
        const int zoff = o ? CV_ZB : CV_ZA;
        conv_mma(lds, zoff, wave, lane, acc);
        const float skip = p.in[I_SKIP][o * 512 + c];
#pragma unroll
        for (int jt = 0; jt < 4; ++jt)
#pragma unroll
            for (int h = 0; h < 2; ++h) { const int P = 8 * wave + 2 * jt + nb, t0 = 32 * P + 16 * h + 4 * fq;
                const u32x2 zi = *(const LAS u32x2*)(lds + zoff + (P + 7) * 512 + b * 64 + (16 * h + 4 * fq) * 2);
                f32x4 y; y.x = acc[jt][h].x + bf2f(zi.x & 0xffffu) * skip; y.y = acc[jt][h].y + bf2f(zi.x >> 16) * skip; y.z = acc[jt][h].z + bf2f(zi.y & 0xffffu) * skip; y.w = acc[jt][h].w + bf2f(zi.y >> 16) * skip;
                const f32x4 gate = o ? x2c[jt][h] : x1c[jt][h]; y = y * gate;
                u32x2 w; w.x = cvt_pk_bf16(y.x, y.y); w.y = cvt_pk_bf16(y.z, y.w);
                if (o == 0) *(LAS u32x2*)(lds + CV_ZB + (P + 7) * 512 + b * 64 + (16 * h + 4 * fq) * 2) = w;
                else *(u32x2*)(YHT + (size_t)c * M + b * SEQ + t0) = w; }
    }
}
typedef short v4i16_t __attribute__((ext_vector_type(4)));
__device__ __forceinline__ s16x4 vtr(const LAS unsigned char* p) { return __builtin_bit_cast(s16x4, __builtin_amdgcn_ds_read_tr16_b64_v4i16((LAS v4i16_t*)p)); }
constexpr int ATT_VROW = 144;
constexpr int ATT_WAVE_LDS = 32 * ATT_VROW;
constexpr int ATT_NPAIR = 23;
__device__ __forceinline__ void att_pair_params(int pi, int tq0, int& st, int& kb) {
    if (pi < 5) { st = 16; kb = tq0 - 1024 + 512 * pi; }
    else if (pi < 11) { st = 4; kb = tq0 - 256 + 128 * (pi - 5); }
    else { st = 1; kb = tq0 - 64 + 32 * (pi - 11); }
}
__device__ __forceinline__ void att_load(const bf16* QKVb, int h, int st, int kb, int lane, bf16x8 (&kf)[2][2], u32x4 (&vv)[4]) {
    const int fr = lane & 15, fq = lane >> 4;
#pragma unroll
    for (int ab = 0; ab < 2; ++ab) { int tk = kb + st * (16 * ab + fr); tk = tk < 0 ? 0 : (tk > SEQ - 1 ? SEQ - 1 : tk);
        const bf16* kp = QKVb + (size_t)tk * NQKV + 512 + h * 64 + 8 * fq;
        kf[ab][0] = *(const bf16x8*)kp; kf[ab][1] = *(const bf16x8*)(kp + 32); }
#pragma unroll
    for (int e = 0; e < 4; ++e) { int tk = kb + st * (8 * e + (lane >> 3)); tk = tk < 0 ? 0 : (tk > SEQ - 1 ? SEQ - 1 : tk);
        vv[e] = *(const u32x4*)(QKVb + (size_t)tk * NQKV + 1024 + h * 64 + (lane & 7) * 8); }
}
struct AttState { float m, lpart; f32x4 oacc[4]; };
__device__ __forceinline__ void att_compute(AttState& S, LAS unsigned char* vl, int st, int kb, int tq, int lane, float slope2, const bf16x8 (&qf)[2], const bf16x8 (&kf)[2][2], const u32x4 (&vv)[4]) {
    const int fr = lane & 15, fq = lane >> 4;
    const float LOG2E = 1.4426950408889634f, NEG = -1e30f, sc2 = 0.125f * LOG2E;
    f32x4 s[2];
#pragma unroll
    for (int ab = 0; ab < 2; ++ab) { s[ab] = (f32x4){0.f, 0.f, 0.f, 0.f};
        s[ab] = __builtin_amdgcn_mfma_f32_16x16x32_bf16(kf[ab][0], qf[0], s[ab], 0, 0, 0);
        s[ab] = __builtin_amdgcn_mfma_f32_16x16x32_bf16(kf[ab][1], qf[1], s[ab], 0, 0, 0); }
#pragma unroll
    for (int e = 0; e < 4; ++e) *(LAS u32x4*)(vl + (8 * e + (lane >> 3)) * ATT_VROW + (lane & 7) * 16) = vv[e];
    float sv[8]; float mx = NEG;
#pragma unroll
    for (int ab = 0; ab < 2; ++ab)
#pragma unroll
        for (int r = 0; r < 4; ++r) { const int tk = kb + st * (16 * ab + 4 * fq + r); const int dl = tk - tq, adl = dl < 0 ? -dl : dl;
            const bool valid = ((unsigned)tk < (unsigned)SEQ) && (adl <= 64 * st);
            const float x = s[ab][r] * sc2 - slope2 * (float)adl; sv[ab * 4 + r] = valid ? x : NEG; mx = fmaxf(mx, sv[ab * 4 + r]); }
    mx = fmaxf(mx, __shfl_xor(mx, 16)); mx = fmaxf(mx, __shfl_xor(mx, 32));
    const float mnew = fmaxf(S.m, mx), alpha = __builtin_amdgcn_exp2f(S.m - mnew); S.m = mnew;
    float pv[8], ps = 0.f;
#pragma unroll
    for (int i = 0; i < 8; ++i) { pv[i] = sv[i] > -1e29f ? __builtin_amdgcn_exp2f(sv[i] - mnew) : 0.f; ps += pv[i]; }
    S.lpart = S.lpart * alpha + ps;
#pragma unroll
    for (int mt = 0; mt < 4; ++mt) S.oacc[mt] = S.oacc[mt] * alpha;
    u32x4 pw; pw.x = cvt_pk_bf16(pv[0], pv[1]); pw.y = cvt_pk_bf16(pv[2], pv[3]); pw.z = cvt_pk_bf16(pv[4], pv[5]); pw.w = cvt_pk_bf16(pv[6], pv[7]);
    const bf16x8 pb = __builtin_bit_cast(bf16x8, pw);
    LDS_WAIT();
    const LAS unsigned char* va = vl + (4 * fq + (fr >> 2)) * ATT_VROW + (fr & 3) * 8;
#pragma unroll
    for (int mt = 0; mt < 4; ++mt) { const s16x4 lo = vtr(va + mt * 32), hi = vtr(va + 16 * ATT_VROW + mt * 32);
        const bf16x8 vf = (bf16x8){lo[0], lo[1], lo[2], lo[3], hi[0], hi[1], hi[2], hi[3]};
        S.oacc[mt] = __builtin_amdgcn_mfma_f32_16x16x32_bf16(vf, pb, S.oacc[mt], 0, 0, 0); }
    LDS_WAIT();
}
__device__ __forceinline__ void attn_item(const Params& p, LAS unsigned char* vl, int item, int lane) {
    const int rcls = item & 15, stile = (item >> 4) & 7, h = (item >> 7) & 7, b = item >> 10;
    const int fr = lane & 15, fq = lane >> 4;
    const bf16* QKVb = (const bf16*)(p.ws + WS_QKV) + (size_t)b * SEQ * NQKV;
    const int tq0 = 256 * stile + rcls, tq = tq0 + 16 * fr;
    bf16x8 qf[2];
    { const bf16* qp = QKVb + (size_t)tq * NQKV + h * 64 + 8 * fq; qf[0] = *(const bf16x8*)qp; qf[1] = *(const bf16x8*)(qp + 32); }
    const float slope2 = __builtin_amdgcn_exp2f(-(float)(h + 1)) * 1.4426950408889634f;
    AttState S; S.m = -1e30f; S.lpart = 0.f;
#pragma unroll
    for (int mt = 0; mt < 4; ++mt) S.oacc[mt] = (f32x4){0.f, 0.f, 0.f, 0.f};
    bf16x8 k0[2][2], k1[2][2], k2[2][2]; u32x4 v0[4], v1[4], v2[4];
    int st, kb;
#define ATT_LOAD(pi, kf, vv) do { att_pair_params((pi), tq0, st, kb); att_load(QKVb, h, st, kb, lane, kf, vv); } while (0)
#define ATT_COMP(pi, kf, vv) do { att_pair_params((pi), tq0, st, kb); att_compute(S, vl, st, kb, tq, lane, slope2, qf, kf, vv); } while (0)
    ATT_LOAD(0, k0, v0); ATT_LOAD(1, k1, v1);
    for (int pi = 0; pi < 21; pi += 3) {
        ATT_LOAD(pi + 2, k2, v2); ATT_COMP(pi, k0, v0);
        ATT_LOAD(pi + 3, k0, v0); ATT_COMP(pi + 1, k1, v1);
        ATT_LOAD(pi + 4, k1, v1); ATT_COMP(pi + 2, k2, v2);
    }
    ATT_COMP(21, k0, v0); ATT_COMP(22, k1, v1);
#undef ATT_LOAD
#undef ATT_COMP
    float l = S.lpart; l += __shfl_xor(l, 16); l += __shfl_xor(l, 32);
    const float inv = 1.0f / l;
    bf16* yp = (bf16*)(p.ws + WS_YA) + (size_t)(b * SEQ + tq) * DH + h * 64 + 4 * fq;
#pragma unroll
    for (int mt = 0; mt < 4; ++mt) { u32x2 w; w.x = cvt_pk_bf16(S.oacc[mt][0] * inv, S.oacc[mt][1] * inv); w.y = cvt_pk_bf16(S.oacc[mt][2] * inv, S.oacc[mt][3] * inv); *(u32x2*)(yp + 16 * mt) = w; }
}

__device__ __forceinline__ void mixnorm_unit(const Params& p, LAS unsigned char* lds, int unit, int tid) {
    constexpr int RS = 136;
    const int m0 = unit * 64, lane = tid & 63, wave = tid >> 6;
    const bf16* YHT = (const bf16*)(p.ws + WS_YHT); const bf16* YA = (const bf16*)(p.ws + WS_YA); bf16* Y = (bf16*)(p.ws + WS_Y);
    __syncthreads();
    { const u32x4* src = (const u32x4*)(YHT + (size_t)tid * M + m0);
#pragma unroll
        for (int q = 0; q < 8; ++q) { const u32x4 v = src[q]; LAS unsigned* d = (LAS unsigned*)(lds + tid * RS + q * 16); d[0] = v.x; d[1] = v.y; d[2] = v.z; d[3] = v.w; } }
    __syncthreads();
    const float* ghy = p.in[I_GHY]; const float* gat = p.in[I_GAT];
    for (int k = 0; k < 8; ++k) {
        const int tok = 8 * wave + k, mrow = m0 + tok;
        float v[8]; float s = 0.f;
#pragma unroll
        for (int q = 0; q < 4; ++q) { const int c = 2 * lane + 128 * q;
            v[2 * q] = bf2f(*(const LAS bf16*)(lds + c * RS + tok * 2)); v[2 * q + 1] = bf2f(*(const LAS bf16*)(lds + (c + 1) * RS + tok * 2));
            s += v[2 * q] * v[2 * q] + v[2 * q + 1] * v[2 * q + 1]; }
        const float rstd = 1.0f / sqrtf(wave_sum(s) * (1.f / DH) + RMS_EPS);
#pragma unroll
        for (int q = 0; q < 4; ++q) { const int c = 2 * lane + 128 * q;
            *(unsigned*)(Y + (size_t)mrow * D + c) = cvt_pk_bf16(v[2 * q] * rstd * ghy[c], v[2 * q + 1] * rstd * ghy[c + 1]); }
        const u32x4 a = *(const u32x4*)(YA + (size_t)mrow * DH + 8 * lane);
        float w[8]; w[0] = bf2f(a.x & 0xffffu); w[1] = bf2f(a.x >> 16); w[2] = bf2f(a.y & 0xffffu); w[3] = bf2f(a.y >> 16); w[4] = bf2f(a.z & 0xffffu); w[5] = bf2f(a.z >> 16); w[6] = bf2f(a.w & 0xffffu); w[7] = bf2f(a.w >> 16);
        float s2 = 0.f;
#pragma unroll
        for (int e = 0; e < 8; ++e) s2 += w[e] * w[e];
        const float rstd2 = 1.0f / sqrtf(wave_sum(s2) * (1.f / DH) + RMS_EPS);
        const f32x4 g0 = *(const f32x4*)(gat + 8 * lane), g1 = *(const f32x4*)(gat + 8 * lane + 4);
        u32x4 o; o.x = cvt_pk_bf16(w[0] * rstd2 * g0.x, w[1] * rstd2 * g0.y); o.y = cvt_pk_bf16(w[2] * rstd2 * g0.z, w[3] * rstd2 * g0.w);
        o.z = cvt_pk_bf16(w[4] * rstd2 * g1.x, w[5] * rstd2 * g1.y); o.w = cvt_pk_bf16(w[6] * rstd2 * g1.z, w[7] * rstd2 * g1.w);
        *(u32x4*)(Y + (size_t)mrow * D + DH + 8 * lane) = o;
    }
}

__device__ __forceinline__ int launder(int v) { asm volatile("" : "+v"(v)); return v; }
__global__ void __launch_bounds__(NWAVES * 64, 2) fwd_kernel(Params p) {
    extern __shared__ __attribute__((aligned(16))) unsigned char lds_raw[];
    LAS unsigned char* lds = (LAS unsigned char*)lds_raw;
    cg::grid_group grid = cg::this_grid();
#define TID() launder((int)threadIdx.x)
#define WAVE() __builtin_amdgcn_readfirstlane((int)(threadIdx.x >> 6))
#define GW() (bx * NWAVES + WAVE())
    const int G = gridDim.x, bx = blockIdx.x;
    const int NGW = G * NWAVES;
    unsigned char* ws = p.ws;
    volatile LAS unsigned* MISC = (volatile LAS unsigned*)(lds + LDS_BYTES - 64);
    unsigned* barw = (unsigned*)(ws + WS_BAR);
    if (threadIdx.x < 16) MISC[threadIdx.x] = 0u;
    if (bx == 0) for (int i = threadIdx.x; i < XCD_BAR_WORDS; i += NWAVES * 64) __hip_atomic_store(barw + i, 0u, __ATOMIC_RELAXED, __HIP_MEMORY_SCOPE_AGENT);
    __syncthreads();
    bf16* W1A = (bf16*)(ws + WS_W1A); bf16* W1D = (bf16*)(ws + WS_W1D); bf16* WIN = (bf16*)(ws + WS_WIN); bf16* WOUT = (bf16*)(ws + WS_WOUT);
    bf16* W2A = (bf16*)(ws + WS_W2A); bf16* W2D = (bf16*)(ws + WS_W2D); bf16* XN = (bf16*)(ws + WS_XN); bf16* HB = (bf16*)(ws + WS_H);
    float* SS = (float*)(ws + WS_SS);
    bf16* PT = (bf16*)(ws + WS_PT); bf16* QKV = (bf16*)(ws + WS_QKV); bf16* Y = (bf16*)(ws + WS_Y);

    {
        const int lane = TID() & 63, gw = GW();
        LAS float* scr = (LAS float*)(lds + WAVE() * 16384);
        constexpr int I_UP = 16 * 88;
        for (int it = gw; it < 2 * I_UP; it += NGW) {
            if (it < I_UP) p0_transpose_mat(p.in[I_WG1], D, FF, W1A, 1, it, scr, lane);
            else p0_transpose_mat(p.in[I_WU1], D, FF, W1A, 2, it - I_UP, scr, lane);
        }
        { const int ln = TID() & 63; for (int m = gw; m < M; m += NGW) rms_row_to_bf16(p.in[I_X] + (size_t)m * D, p.in[I_G1], XN + (size_t)m * D, ln); }
        { float* ss = (float*)(ws + WS_SS); for (int i = bx * NWAVES * 64 + (int)threadIdx.x; i < 3 * M; i += G * NWAVES * 64) ss[i] = 0.f; }
        __syncthreads();
        filt_gen(p, lds, TID());
    }
    grid.sync();
    const XcdBarrier bar = xcd_barrier_post(barw, MISC + 8);
    {
        pg8::Gemm g{XN, W1A, M, 2 * FF, D, nullptr, nullptr}; pg8::StaticOrder S; S.init(M, 2 * FF, G, bx);
        pg8::EpiSwiglu E{HB, FF, nullptr};
        pg8::gemm_phase<pg8::EpiSwiglu, pg8::StaticOrder, true, true>(lds, g, S, E);
    }
    {
        constexpr int I_UP = 16 * 88, I_DN = 44 * 32, I_IN = 16 * 96, I_OUT = 16 * 32, NLATE = 2 * I_DN + 2 * I_UP + I_IN + I_OUT;
        const int nshort = G - (1408 % G == 0 ? 0 : 1408 % G), first = G - nshort;
        if (bx >= first) {
            const int lane = TID() & 63; LAS float* scr = (LAS float*)(lds + WAVE() * 16384);
            for (int it = (bx - first) * NWAVES + WAVE(); it < NLATE; it += nshort * NWAVES) {
                int r = it;
                if (r < I_DN) { p0_transpose_mat(p.in[I_WD1], FF, D, W1D, 0, r, scr, lane); continue; } r -= I_DN;
                if (r < I_IN) { p0_transpose_mat(p.in[I_WIN], D, 3072, WIN, 0, r, scr, lane); continue; } r -= I_IN;
                if (r < I_OUT) { p0_transpose_mat(p.in[I_WOUT], D, D, WOUT, 0, r, scr, lane); continue; } r -= I_OUT;
                if (r < I_UP) { p0_transpose_mat(p.in[I_WG2], D, FF, W2A, 1, r, scr, lane); continue; } r -= I_UP;
                if (r < I_UP) { p0_transpose_mat(p.in[I_WU2], D, FF, W2A, 2, r, scr, lane); continue; } r -= I_UP;
                p0_transpose_mat(p.in[I_WD2], FF, D, W2D, 0, r, scr, lane);
            }
        }
    }
    xcd_barrier(bar);
    {
        pg8::Gemm g{HB, W1D, M, D, FF, nullptr, nullptr}; pg8::StaticOrder S; S.init(M, D, G, bx);
        pg8::EpiResid E{p.in[I_X], p.out, D, 0.5f, XN, p.in[I_GMIX], SS};
        pg8::gemm_phase<pg8::EpiResid, pg8::StaticOrder, true, true>(lds, g, S, E);
    }
    xcd_barrier(bar);
    {
        pg8::Gemm g{WIN, XN, 0, 0, D, XN, WIN + (size_t)NQKV * D}; pg8::WinOrder S; S.init(G, bx);
        pg8::EpiStore2 E{PT, M, QKV, NQKV, SS};
        pg8::gemm_phase<pg8::EpiStore2, pg8::WinOrder, true, true>(lds, g, S, E);
    }
    xcd_barrier(bar);
    { const int td = TID(); for (int c = bx; c < DH; c += G) conv_unit_mfma(p, lds, c, td); }
    __syncthreads();
    { const int ln = TID() & 63, vb = (G % 8 == 0) ? (bx % 8) * (G / 8) + bx / 8 : bx, gwv = vb * NWAVES + WAVE();
      for (int it = gwv; it < 8192; it += NGW) attn_item(p, lds + WAVE() * ATT_WAVE_LDS, it, ln); }
    xcd_barrier(bar);
    { const int td = TID(); for (int u = bx; u < M / 64; u += G) mixnorm_unit(p, lds, u, td); }
    __syncthreads();
    xcd_barrier(bar);
    {
        pg8::Gemm g{Y, WOUT, M, D, D, nullptr, nullptr}; pg8::StaticOrder S; S.init(M, D, G, bx);
        pg8::EpiResid E{p.out, p.out, D, 1.0f, XN, p.in[I_G2], SS + M};
        pg8::gemm_phase<pg8::EpiResid, pg8::StaticOrder, true, true>(lds, g, S, E);
    }
    xcd_barrier(bar);
    {
        pg8::Gemm g{XN, W2A, M, 2 * FF, D, nullptr, nullptr}; pg8::StaticOrder S; S.init(M, 2 * FF, G, bx);
        pg8::EpiSwiglu E{HB, FF, SS + M};
        pg8::gemm_phase<pg8::EpiSwiglu, pg8::StaticOrder, true, true>(lds, g, S, E);
    }
    xcd_barrier(bar);
    {
        pg8::Gemm g{HB, W2D, M, D, FF, nullptr, nullptr}; pg8::StaticOrder S; S.init(M, D, G, bx);
        pg8::EpiResid E{p.out, p.out, D, 0.5f, nullptr, nullptr, SS + 2 * M};
        pg8::gemm_phase<pg8::EpiResid, pg8::StaticOrder, true, true>(lds, g, S, E);
    }
    xcd_barrier(bar);
    { const int ln = TID() & 63, gw = GW(); for (int m = gw; m < M; m += NGW) rms_row_to_f32_ss(p.out + (size_t)m * D, p.in[I_GFIN], p.out + (size_t)m * D, __hip_atomic_load(SS + 2 * M + m, __ATOMIC_RELAXED, __HIP_MEMORY_SCOPE_AGENT), ln); }
}

extern "C" void kernel_launch(void* const* d_in, const int* in_sizes, int n_in, void* d_out, int out_size, void* d_ws, size_t ws_size, hipStream_t stream) {
    static int grid = 0;
    if (grid == 0) {
        if (n_in != 26 || in_sizes[0] != M * D || out_size != M * D || ws_size < WS_END) { fprintf(stderr, "kernel_launch: unexpected shapes (n_in %d, in0 %d, out %d, ws %zu)\n", n_in, n_in > 0 ? in_sizes[0] : -1, out_size, ws_size); grid = -1; return; }
        int dev = 0, cus = 0, per_cu = 0;
        hipGetDevice(&dev); hipDeviceGetAttribute(&cus, hipDeviceAttributeMultiprocessorCount, dev);
        if (hipFuncSetAttribute((const void*)fwd_kernel, hipFuncAttributeMaxDynamicSharedMemorySize, LDS_BYTES) != hipSuccess) { fprintf(stderr, "kernel_launch: hipFuncSetAttribute failed\n"); grid = -1; return; }
        if (hipOccupancyMaxActiveBlocksPerMultiprocessor(&per_cu, (const void*)fwd_kernel, NWAVES * 64, LDS_BYTES) != hipSuccess || per_cu < 1) { fprintf(stderr, "kernel_launch: occupancy query says %d blocks per CU\n", per_cu); (void)hipGetLastError(); grid = -1; return; }
        grid = cus;
    }
    if (grid < 0) return;
    Params prm{};
    for (int i = 0; i < 26; ++i) prm.in[i] = (const float*)d_in[i];
    prm.out = (float*)d_out; prm.ws = (unsigned char*)d_ws;
    void* args[] = {&prm};
    hipError_t e = hipLaunchCooperativeKernel((const void*)fwd_kernel, dim3(grid), dim3(NWAVES * 64), args, LDS_BYTES, stream);
    if (e != hipSuccess) fprintf(stderr, "kernel_launch: cooperative launch failed: %s (grid %d)\n", hipGetErrorString(e), grid);
}
```
